# Optimizing an MI355X kernel written in HIP

```python
import math
import jax, jax.numpy as jnp
from jax import lax
import numpy as np

D_MODEL = 1024
BATCH = 16
SEQ = 2048
DEPTH = 1

N_Q_HEADS = 16
N_KV_HEADS = 2
HEAD_DIM = 64
WINDOW = 128
ROPE_THETA = 10000.0
Q_WIDTH = N_Q_HEADS * HEAD_DIM
KV_WIDTH = N_KV_HEADS * HEAD_DIM
SSM_GROUP = 16
SSM_GROUPS = 32
SSM_WIDTH = SSM_GROUP * SSM_GROUPS
SSM_STATE = 64
DT_MIN = 0.001
DT_MAX = 0.1
IN_WIDTH = Q_WIDTH + 2 * KV_WIDTH + SSM_WIDTH + 2 * D_MODEL
N_MEM = 256
N_CROSS_HEADS = 4
CROSS_HEAD_DIM = D_MODEL // N_CROSS_HEADS
N_EXPERTS = 32
TOP_K = 4
D_EXPERT = D_MODEL
SWIGLU_ALPHA = 1.702
SWIGLU_LIMIT = 7.0
MOE_BLOCK = 256
LN_EPS = 1e-5
DEEPNORM_ALPHA = (2 * DEPTH) ** 0.25
DEEPNORM_BETA = (8 * DEPTH) ** -0.25

kernel_name = "hybrid_swa_s5_moe_deepnorm"


def layer_norm(x, g, b):
    xf = x.astype(jnp.float32)
    mu = jnp.mean(xf, axis=-1, keepdims=True)
    var = jnp.mean(jnp.square(xf - mu), axis=-1, keepdims=True)
    return ((xf - mu) * lax.rsqrt(var + LN_EPS)).astype(x.dtype) * g + b


def rope(t, positions):
    half = HEAD_DIM // 2
    inv_freq = jnp.power(ROPE_THETA, -jnp.arange(half, dtype=jnp.float32) / half)
    ang = positions.astype(jnp.float32)[..., None] * inv_freq
    cos = jnp.cos(ang)[:, :, None, :]
    sin = jnp.sin(ang)[:, :, None, :]
    t1 = t[..., :half].astype(jnp.float32)
    t2 = t[..., half:].astype(jnp.float32)
    out = jnp.concatenate([t1 * cos - t2 * sin, t2 * cos + t1 * sin], axis=-1)
    return out.astype(t.dtype)


def sliding_window_gqa(q, k, v, sinks):
    bsz, seq = q.shape[0], q.shape[1]
    nb = seq // WINDOW
    rep = N_Q_HEADS // N_KV_HEADS
    qb = q.reshape(bsz, nb, WINDOW, N_KV_HEADS, rep, HEAD_DIM)

    def band(t):
        tb = t.reshape(bsz, nb, WINDOW, N_KV_HEADS, HEAD_DIM)
        prev = jnp.pad(tb, ((0, 0), (1, 0), (0, 0), (0, 0), (0, 0)))[:, :-1]
        return jnp.concatenate([prev, tb], axis=2)

    kb, vb = band(k), band(v)
    scores = jnp.einsum('bnqkrd,bnckd->bnkrqc', qb, kb).astype(jnp.float32) * (HEAD_DIM ** -0.5)
    qi = jnp.arange(WINDOW)[:, None]
    ci = jnp.arange(2 * WINDOW)[None, :]
    diff = qi + WINDOW - ci
    local = (diff >= 0) & (diff < WINDOW)
    kpos = jnp.arange(nb)[:, None] * WINDOW + ci - WINDOW
    mask = local[None] & (kpos >= 0)[:, None, :]
    scores = jnp.where(mask[None, :, None, None], scores, -jnp.inf)
    sink = sinks.astype(jnp.float32).reshape(N_KV_HEADS, rep)[None, None, :, :, None, None]
    m = jnp.maximum(jnp.max(scores, axis=-1, keepdims=True), sink)
    p = jnp.exp(scores - m)
    w = p / (jnp.sum(p, axis=-1, keepdims=True) + jnp.exp(sink - m))
    out = jnp.einsum('bnkrqc,bnckd->bnqkrd', w.astype(v.dtype), vb)
    return out.reshape(bsz, seq, Q_WIDTH)


def s5_ssm(u, lam_re, lam_im, log_dt, b_re, b_im, c_re, c_im, d_skip):
    bsz, seq = u.shape[0], u.shape[1]
    uf = u.astype(jnp.float32).reshape(bsz, seq, SSM_GROUPS, SSM_GROUP)
    lr = lam_re.astype(jnp.float32)
    li = lam_im.astype(jnp.float32)
    dt = jnp.exp(log_dt.astype(jnp.float32))[:, None]
    mag = jnp.exp(lr * dt)
    abar_re = mag * jnp.cos(li * dt)
    abar_im = mag * jnp.sin(li * dt)
    den = lr * lr + li * li
    f_re = ((abar_re - 1.0) * lr + abar_im * li) / den
    f_im = (abar_im * lr - (abar_re - 1.0) * li) / den
    br = b_re.astype(jnp.float32)
    bi = b_im.astype(jnp.float32)
    bbar_re = f_re[..., None] * br - f_im[..., None] * bi
    bbar_im = f_re[..., None] * bi + f_im[..., None] * br
    bu_re = jnp.einsum('bsgh,gph->bsgp', uf, bbar_re)
    bu_im = jnp.einsum('bsgh,gph->bsgp', uf, bbar_im)
    a_re = jnp.broadcast_to(abar_re, (1, seq, SSM_GROUPS, SSM_STATE))
    a_im = jnp.broadcast_to(abar_im, (1, seq, SSM_GROUPS, SSM_STATE))

    def combine(e1, e2):
        a1r, a1i, b1r, b1i = e1
        a2r, a2i, b2r, b2i = e2
        return (a2r * a1r - a2i * a1i,
                a2r * a1i + a2i * a1r,
                a2r * b1r - a2i * b1i + b2r,
                a2r * b1i + a2i * b1r + b2i)

    _, _, h_re, h_im = lax.associative_scan(combine, (a_re, a_im, bu_re, bu_im), axis=1)
    y = (jnp.einsum('bsgp,ghp->bsgh', h_re, c_re.astype(jnp.float32))
         - jnp.einsum('bsgp,ghp->bsgh', h_im, c_im.astype(jnp.float32)))
    y = y + d_skip.astype(jnp.float32).reshape(SSM_GROUPS, SSM_GROUP) * uf
    return y.reshape(bsz, seq, SSM_WIDTH).astype(u.dtype)


def memory_cross_attention(x, mem, wq, wk, wv, wo):
    bsz, seq = x.shape[0], x.shape[1]
    n_mem = mem.shape[1]
    q = (x @ wq).reshape(bsz, seq, N_CROSS_HEADS, CROSS_HEAD_DIM)
    k = (mem @ wk).reshape(bsz, n_mem, N_CROSS_HEADS, CROSS_HEAD_DIM)
    v = (mem @ wv).reshape(bsz, n_mem, N_CROSS_HEADS, CROSS_HEAD_DIM)
    s = jnp.einsum('bshd,bmhd->bhsm', q, k).astype(jnp.float32) * (CROSS_HEAD_DIM ** -0.5)
    w = jax.nn.softmax(s, axis=-1).astype(x.dtype)
    o = jnp.einsum('bhsm,bmhd->bshd', w, v).reshape(bsz, seq, D_MODEL)
    return o @ wo


def clamped_swiglu(gu):
    g = jnp.minimum(gu[..., ::2], SWIGLU_LIMIT)
    lin = jnp.clip(gu[..., 1::2], -SWIGLU_LIMIT, SWIGLU_LIMIT)
    return g * jax.nn.sigmoid(SWIGLU_ALPHA * g) * (lin + 1.0)


def moe_ffn(h, w_router, b_router, w_gate_up, b_gate_up, w_down, b_down):
    n_tok = h.shape[0]
    logits = (h @ w_router + b_router).astype(jnp.float32)
    top_val, top_idx = lax.top_k(logits, TOP_K)
    gates = jax.nn.softmax(top_val, axis=-1).astype(h.dtype)
    n_assign = n_tok * TOP_K
    flat_e = top_idx.reshape(-1)
    flat_tok = jnp.repeat(jnp.arange(n_tok, dtype=jnp.int32), TOP_K)
    flat_gate = gates.reshape(-1)
    order = jnp.argsort(flat_e)
    sorted_e = flat_e[order]
    counts = jnp.bincount(flat_e, length=N_EXPERTS)
    padded = (counts + MOE_BLOCK - 1) // MOE_BLOCK * MOE_BLOCK
    ends_pad = jnp.cumsum(padded)
    start_pad = ends_pad - padded
    start = jnp.cumsum(counts) - counts
    dest = start_pad[sorted_e] + jnp.arange(n_assign, dtype=jnp.int32) - start[sorted_e]
    n_blocks = -(-n_assign // MOE_BLOCK) + N_EXPERTS
    n_slots = n_blocks * MOE_BLOCK
    slot_tok = jnp.zeros((n_slots,), jnp.int32).at[dest].set(flat_tok[order])
    slot_gate = jnp.zeros((n_slots,), h.dtype).at[dest].set(flat_gate[order])
    block_start = jnp.arange(n_blocks, dtype=ends_pad.dtype) * MOE_BLOCK
    block_expert = jnp.minimum(jnp.searchsorted(ends_pad, block_start, side='right'), N_EXPERTS - 1)
    xb = h[slot_tok].reshape(n_blocks, MOE_BLOCK, h.shape[1])

    def run_block(args):
        xblk, e = args
        gu = xblk @ w_gate_up[e] + b_gate_up[e]
        return clamped_swiglu(gu) @ w_down[e] + b_down[e]

    yb = lax.map(run_block, (xb, block_expert))
    y = yb.reshape(n_slots, h.shape[1]) * slot_gate[:, None]
    return jax.ops.segment_sum(y, slot_tok, num_segments=n_tok)


def setup_inputs(seed: int = 0) -> dict:
    key = jax.random.key(seed)
    ks = iter(jax.random.split(key, 40))
    L = DEPTH

    def nrm(shape, scale):
        return jax.random.normal(next(ks), shape, jnp.float32) * scale

    x = nrm((BATCH, SEQ, D_MODEL), 1.0)
    mem = nrm((BATCH, N_MEM, D_MODEL), 1.0)
    offset = jax.random.randint(next(ks), (BATCH, 1), 0, 1024, dtype=jnp.int32)
    positions = (jnp.arange(SEQ, dtype=jnp.int32)[None, :] + offset).astype(jnp.int32)

    w_in = nrm((L, D_MODEL, IN_WIDTH), D_MODEL ** -0.5)
    sinks = nrm((L, N_Q_HEADS), 0.5)
    w_attn_o = nrm((L, Q_WIDTH, D_MODEL), Q_WIDTH ** -0.5)
    lam_re = -0.5 + nrm((L, SSM_GROUPS, SSM_STATE), 0.01)
    lam_im = (math.pi * jnp.arange(SSM_STATE, dtype=jnp.float32))[None, None, :] + nrm((L, SSM_GROUPS, SSM_STATE), 0.01)
    log_dt = jax.random.uniform(next(ks), (L, SSM_GROUPS), jnp.float32, math.log(DT_MIN), math.log(DT_MAX))
    b_re = nrm((L, SSM_GROUPS, SSM_STATE, SSM_GROUP), (2 * SSM_GROUP) ** -0.5)
    b_im = nrm((L, SSM_GROUPS, SSM_STATE, SSM_GROUP), (2 * SSM_GROUP) ** -0.5)
    c_re = nrm((L, SSM_GROUPS, SSM_GROUP, SSM_STATE), (2 * SSM_STATE) ** -0.5)
    c_im = nrm((L, SSM_GROUPS, SSM_GROUP, SSM_STATE), (2 * SSM_STATE) ** -0.5)
    d_skip = nrm((L, SSM_WIDTH), 1.0)
    w_glu_a = nrm((L, SSM_WIDTH, D_MODEL), SSM_WIDTH ** -0.5)
    w_glu_b = nrm((L, SSM_WIDTH, D_MODEL), SSM_WIDTH ** -0.5)
    w_out = nrm((L, D_MODEL, D_MODEL), D_MODEL ** -0.5 * DEEPNORM_BETA)
    ln1_g = 1.0 + nrm((L, D_MODEL), 0.05)
    ln1_b = nrm((L, D_MODEL), 0.02)

    wq_c = nrm((L, D_MODEL, D_MODEL), D_MODEL ** -0.5)
    wk_c = nrm((L, D_MODEL, D_MODEL), D_MODEL ** -0.5)
    wv_c = nrm((L, D_MODEL, D_MODEL), D_MODEL ** -0.5)
    wo_c = nrm((L, D_MODEL, D_MODEL), D_MODEL ** -0.5 * DEEPNORM_BETA)
    ln2_g = 1.0 + nrm((L, D_MODEL), 0.05)
    ln2_b = nrm((L, D_MODEL), 0.02)

    w_router = nrm((L, D_MODEL, N_EXPERTS), D_MODEL ** -0.5)
    b_router = nrm((L, N_EXPERTS), 0.01)
    w_gate_up = nrm((L, N_EXPERTS, D_MODEL, 2 * D_EXPERT), D_MODEL ** -0.5)
    b_gate_up = nrm((L, N_EXPERTS, 2 * D_EXPERT), 0.02)
    w_down = nrm((L, N_EXPERTS, D_EXPERT, D_MODEL), D_EXPERT ** -0.5 * DEEPNORM_BETA)
    b_down = nrm((L, N_EXPERTS, D_MODEL), 0.02)
    ln3_g = 1.0 + nrm((L, D_MODEL), 0.05)
    ln3_b = nrm((L, D_MODEL), 0.02)

    return {"x": x, "mem": mem, "positions": positions,
            "w_in": w_in, "sinks": sinks, "w_attn_o": w_attn_o,
            "lam_re": lam_re, "lam_im": lam_im, "log_dt": log_dt,
            "b_re": b_re, "b_im": b_im, "c_re": c_re, "c_im": c_im, "d_skip": d_skip,
            "w_glu_a": w_glu_a, "w_glu_b": w_glu_b, "w_out": w_out,
            "ln1_g": ln1_g, "ln1_b": ln1_b,
            "wq_c": wq_c, "wk_c": wk_c, "wv_c": wv_c, "wo_c": wo_c,
            "ln2_g": ln2_g, "ln2_b": ln2_b,
            "w_router": w_router, "b_router": b_router,
            "w_gate_up": w_gate_up, "b_gate_up": b_gate_up,
            "w_down": w_down, "b_down": b_down,
            "ln3_g": ln3_g, "ln3_b": ln3_b}


def reference(x, mem, positions, w_in, sinks, w_attn_o, lam_re, lam_im, log_dt,
              b_re, b_im, c_re, c_im, d_skip, w_glu_a, w_glu_b, w_out, ln1_g, ln1_b,
              wq_c, wk_c, wv_c, wo_c, ln2_g, ln2_b, w_router, b_router,
              w_gate_up, b_gate_up, w_down, b_down, ln3_g, ln3_b):
    bsz, seq, d = x.shape
    o_k = Q_WIDTH
    o_v = o_k + KV_WIDTH
    o_s = o_v + KV_WIDTH
    o_ga = o_s + SSM_WIDTH
    o_gs = o_ga + D_MODEL
    for l in range(DEPTH):
        proj = x @ w_in[l]
        q = rope(proj[..., :o_k].reshape(bsz, seq, N_Q_HEADS, HEAD_DIM), positions)
        k = rope(proj[..., o_k:o_v].reshape(bsz, seq, N_KV_HEADS, HEAD_DIM), positions)
        v = proj[..., o_v:o_s].reshape(bsz, seq, N_KV_HEADS, HEAD_DIM)
        u_ssm = proj[..., o_s:o_ga]
        gate_a = jax.nn.sigmoid(proj[..., o_ga:o_gs])
        gate_s = jax.nn.sigmoid(proj[..., o_gs:])

        attn_out = sliding_window_gqa(q, k, v, sinks[l]) @ w_attn_o[l]

        y_ssm = s5_ssm(u_ssm, lam_re[l], lam_im[l], log_dt[l], b_re[l], b_im[l],
                       c_re[l], c_im[l], d_skip[l])
        z = jax.nn.gelu(y_ssm)
        ssm_out = (z @ w_glu_a[l]) * jax.nn.sigmoid(z @ w_glu_b[l])

        mixed = (gate_a * attn_out + gate_s * ssm_out) @ w_out[l]
        x = layer_norm(DEEPNORM_ALPHA * x + mixed, ln1_g[l], ln1_b[l])

        cross = memory_cross_attention(x, mem, wq_c[l], wk_c[l], wv_c[l], wo_c[l])
        x = layer_norm(DEEPNORM_ALPHA * x + cross, ln2_g[l], ln2_b[l])

        ffn = moe_ffn(x.reshape(bsz * seq, d), w_router[l], b_router[l], w_gate_up[l],
                      b_gate_up[l], w_down[l], b_down[l]).reshape(bsz, seq, d)
        x = layer_norm(DEEPNORM_ALPHA * x + ffn, ln3_g[l], ln3_b[l])
    return x
```

```cpp
#include <hip/hip_runtime.h>
#include <cstdio>
#include <cstdint>
#include <cmath>

constexpr int BATCH = 16, SEQ = 2048, D = 1024, T = BATCH * SEQ;
constexpr int NQH = 16, NKVH = 2, HD = 64, WINDOW = 128;
constexpr int QW = 1024, KVW = 128, SSMW = 512, SSM_G = 32, SSM_H = 16, SSM_P = 64;
constexpr int INW = QW + 2 * KVW + SSMW + 2 * D;
constexpr int O_K = QW, O_V = O_K + KVW, O_S = O_V + KVW, O_GA = O_S + SSMW, O_GS = O_GA + D;
constexpr int NMEM = 256, NCH = 4, CHD = 256;
constexpr int NE = 32, TOPK = 4, DE = 1024;
constexpr float LN_EPS = 1e-5f;
constexpr float ALPHA = 1.189207115002721f;
constexpr int NASSIGN = T * TOPK;

namespace nv {
template <class Epi>
__global__ __launch_bounds__(256) void sgemm(const float* __restrict__ A, const int* __restrict__ ridx,
                                             const float* __restrict__ B, const int* __restrict__ tile_e, size_t bstride,
                                             int lda, int ldb, int M, int N, int K, int pad_, Epi epi) {
    __shared__ float As[16][68];
    __shared__ float Bs[16][68];
    const int tid = threadIdx.x, tx = tid & 15, ty = tid >> 4;
    const int m0 = blockIdx.y * 64, n0 = blockIdx.x * 64;
    int e = 0;
    if (tile_e) { e = tile_e[blockIdx.y]; if (e < 0) return; }
    const float* Bp = B + (size_t)e * bstride;
    float acc[4][4];
#pragma unroll
    for (int i = 0; i < 4; ++i)
#pragma unroll
        for (int j = 0; j < 4; ++j) acc[i][j] = 0.f;
    const int arow = tid >> 2, akq = (tid & 3) * 4;
    long asrc = -1;
    if (m0 + arow < M) { int r = m0 + arow; if (ridx) r = ridx[r]; asrc = (long)r * lda; }
    const int brow = tid >> 4, bcol = (tid & 15) * 4;
    for (int k0 = 0; k0 < K; k0 += 16) {
        float4 a = make_float4(0.f, 0.f, 0.f, 0.f);
        if (asrc >= 0) a = *(const float4*)(A + asrc + k0 + akq);
        As[akq + 0][arow] = a.x; As[akq + 1][arow] = a.y; As[akq + 2][arow] = a.z; As[akq + 3][arow] = a.w;
        float4 b = make_float4(0.f, 0.f, 0.f, 0.f);
        if (n0 + bcol < N) b = *(const float4*)(Bp + (size_t)(k0 + brow) * ldb + n0 + bcol);
        Bs[brow][bcol + 0] = b.x; Bs[brow][bcol + 1] = b.y; Bs[brow][bcol + 2] = b.z; Bs[brow][bcol + 3] = b.w;
        __syncthreads();
#pragma unroll
        for (int kk = 0; kk < 16; ++kk) {
            float av[4], bv[4];
#pragma unroll
            for (int i = 0; i < 4; ++i) av[i] = As[kk][ty * 4 + i];
#pragma unroll
            for (int j = 0; j < 4; ++j) bv[j] = Bs[kk][tx * 4 + j];
#pragma unroll
            for (int i = 0; i < 4; ++i)
#pragma unroll
                for (int j = 0; j < 4; ++j) acc[i][j] = fmaf(av[i], bv[j], acc[i][j]);
        }
        __syncthreads();
    }
#pragma unroll
    for (int i = 0; i < 4; ++i) {
        const int r = m0 + ty * 4 + i;
        if (r < M && n0 + tx * 4 < N) epi(r, n0 + tx * 4, acc[i], e);
    }
}

struct EpiStore { float* C; int ldc; int pad_;
    __device__ void operator()(int r, int c, const float (&v)[4], int) const { *(float4*)(C + (size_t)r * ldc + c) = make_float4(v[0], v[1], v[2], v[3]); } };
struct EpiStoreScale { float* C; int ldc; float s;
    __device__ void operator()(int r, int c, const float (&v)[4], int) const { *(float4*)(C + (size_t)r * ldc + c) = make_float4(v[0] * s, v[1] * s, v[2] * s, v[3] * s); } };
__device__ __forceinline__ float sigmoidf_(float x) { return 1.f / (1.f + expf(-x)); }
struct EpiMix { float* attn_out; const float* glu_a; const float* proj;
    __device__ void operator()(int r, int c, const float (&v)[4], int) const {
#pragma unroll
        for (int j = 0; j < 4; ++j) { const size_t o = (size_t)r * D + c + j;
            const float ga = sigmoidf_(proj[(size_t)r * INW + O_GA + c + j]), gs = sigmoidf_(proj[(size_t)r * INW + O_GS + c + j]);
            attn_out[o] = ga * attn_out[o] + gs * (glu_a[o] * sigmoidf_(v[j])); } } };
struct EpiResid { float* C; const float* res;
    __device__ void operator()(int r, int c, const float (&v)[4], int) const {
#pragma unroll
        for (int j = 0; j < 4; ++j) { const size_t o = (size_t)r * D + c + j; C[o] = ALPHA * res[o] + v[j]; } } };
struct EpiBias { float* C; const float* bias; int ldc; int N;
    __device__ void operator()(int r, int c, const float (&v)[4], int) const {
#pragma unroll
        for (int j = 0; j < 4; ++j) if (c + j < N) C[(size_t)r * ldc + c + j] = v[j] + bias[c + j]; } };
struct EpiSwiglu { float* H; const float* bgu;
    __device__ void operator()(int r, int c, const float (&v)[4], int e) const {
#pragma unroll
        for (int j = 0; j < 2; ++j) {
            float g = v[2 * j] + bgu[(size_t)e * 2 * DE + c + 2 * j], l = v[2 * j + 1] + bgu[(size_t)e * 2 * DE + c + 2 * j + 1];
            g = fminf(g, 7.0f); l = fminf(fmaxf(l, -7.0f), 7.0f);
            H[(size_t)r * DE + (c >> 1) + j] = g * sigmoidf_(1.702f * g) * (l + 1.0f); } } };
struct EpiDown { float* pre3; const float* bd; const int* slot_tok; const float* slot_gate;
    __device__ void operator()(int r, int c, const float (&v)[4], int e) const {
        const float g = slot_gate[r]; if (g == 0.f) return; const int tok = slot_tok[r];
#pragma unroll
        for (int j = 0; j < 4; ++j) atomicAdd(pre3 + (size_t)tok * D + c + j, (v[j] + bd[(size_t)e * D + c + j]) * g); } };

__global__ void rope_k(float* proj, const int* pos) {
    const size_t gid = (size_t)blockIdx.x * blockDim.x + threadIdx.x;
    if (gid >= (size_t)T * 18 * 32) return;
    const int i = gid & 31; const int hh = (gid >> 5) % 18; const size_t tok = gid / (18 * 32);
    const float inv = powf(10000.0f, -(float)i / 32.0f);
    const float ang = (float)pos[tok] * inv; const float c = cosf(ang), s = sinf(ang);
    float* p = proj + tok * INW + (hh < 16 ? hh * 64 : O_K + (hh - 16) * 64);
    const float t1 = p[i], t2 = p[i + 32];
    p[i] = t1 * c - t2 * s; p[i + 32] = t2 * c + t1 * s;
}
__global__ __launch_bounds__(64) void swa_k(const float* __restrict__ proj, const float* __restrict__ sinks, float* __restrict__ out) {
    const int gid = blockIdx.x * blockDim.x + threadIdx.x;
    if (gid >= T * NQH) return;
    const int hq = gid % NQH, tok = gid / NQH, t = tok % SEQ, b = tok / SEQ, kvh = hq / 8;
    float q[64], acc[64];
    const float* qp = proj + (size_t)tok * INW + hq * 64;
#pragma unroll
    for (int d = 0; d < 64; ++d) { q[d] = qp[d] * 0.125f; acc[d] = 0.f; }
    float m = sinks[hq], l = 1.0f;
    const int k0 = t - (WINDOW - 1) < 0 ? 0 : t - (WINDOW - 1);
    for (int kp = k0; kp <= t; ++kp) {
        const float* kr = proj + (size_t)(b * SEQ + kp) * INW + O_K + kvh * 64;
        const float* vr = proj + (size_t)(b * SEQ + kp) * INW + O_V + kvh * 64;
        float s = 0.f;
#pragma unroll
        for (int d = 0; d < 64; ++d) s = fmaf(q[d], kr[d], s);
        if (s > m) { const float sc = expf(m - s); l *= sc;
#pragma unroll
            for (int d = 0; d < 64; ++d) acc[d] *= sc;
            m = s; }
        const float p = expf(s - m); l += p;
#pragma unroll
        for (int d = 0; d < 64; ++d) acc[d] = fmaf(p, vr[d], acc[d]);
    }
    const float il = 1.0f / l;
    float* op = out + (size_t)tok * QW + hq * 64;
#pragma unroll
    for (int d = 0; d < 64; ++d) op[d] = acc[d] * il;
}
__global__ void ssm_pre_k(const float* lam_re, const float* lam_im, const float* log_dt, const float* b_re, const float* b_im,
                          float* abar, float* bbar) {
    const int gp = blockIdx.x * blockDim.x + threadIdx.x; if (gp >= SSM_G * SSM_P) return;
    const int g = gp / SSM_P;
    const float lr = lam_re[gp], li = lam_im[gp], dt = expf(log_dt[g]);
    const float mag = expf(lr * dt), ar = mag * cosf(li * dt), ai = mag * sinf(li * dt);
    const float den = lr * lr + li * li;
    const float fr = ((ar - 1.0f) * lr + ai * li) / den, fi = (ai * lr - (ar - 1.0f) * li) / den;
    abar[gp * 2] = ar; abar[gp * 2 + 1] = ai;
    for (int h = 0; h < 16; ++h) { const float br = b_re[gp * 16 + h], bi = b_im[gp * 16 + h];
        bbar[(gp * 2) * 16 + h] = fr * br - fi * bi; bbar[(gp * 2 + 1) * 16 + h] = fr * bi + fi * br; }
}
__device__ __forceinline__ float gelu_tanh(float x) { return 0.5f * x * (1.0f + tanhf(0.7978845608028654f * (x + 0.044715f * x * x * x))); }
__global__ __launch_bounds__(64) void ssm_scan_k(const float* __restrict__ proj, const float* __restrict__ abar, const float* __restrict__ bbar,
                                                 const float* __restrict__ c_re, const float* __restrict__ c_im, const float* __restrict__ d_skip, float* __restrict__ z) {
    const int g = blockIdx.x % SSM_G, b = blockIdx.x / SSM_G, p = threadIdx.x, gp = g * SSM_P + p;
    const float ar = abar[gp * 2], ai = abar[gp * 2 + 1];
    float br[16], bi[16], cr[16], ci[16];
#pragma unroll
    for (int h = 0; h < 16; ++h) { br[h] = bbar[(gp * 2) * 16 + h]; bi[h] = bbar[(gp * 2 + 1) * 16 + h];
        cr[h] = c_re[(g * 16 + h) * SSM_P + p]; ci[h] = c_im[(g * 16 + h) * SSM_P + p]; }
    const float dsk = p < 16 ? d_skip[g * 16 + p] : 0.f;
    const int pu = p < 16 ? p : 0;
    float hr = 0.f, hi = 0.f;
    for (int t = 0; t < SEQ; ++t) {
        const float* up = proj + (size_t)(b * SEQ + t) * INW + O_S + g * 16;
        float u[16];
#pragma unroll
        for (int h = 0; h < 16; ++h) u[h] = up[h];
        float bur = 0.f, bui = 0.f;
#pragma unroll
        for (int h = 0; h < 16; ++h) { bur = fmaf(br[h], u[h], bur); bui = fmaf(bi[h], u[h], bui); }
        const float nr = ar * hr - ai * hi + bur, ni = ar * hi + ai * hr + bui; hr = nr; hi = ni;
        float mine = 0.f;
#pragma unroll
        for (int h = 0; h < 16; ++h) { float v = cr[h] * hr - ci[h] * hi;
#pragma unroll
            for (int o = 32; o >= 1; o >>= 1) v += __shfl_xor(v, o);
            if (p == h) mine = v; }
        const float uown = up[pu];
        if (p < 16) { const float y = mine + dsk * uown; z[(size_t)(b * SEQ + t) * SSMW + g * 16 + p] = gelu_tanh(y); }
    }
}
__global__ __launch_bounds__(256) void ln_k(const float* __restrict__ in, const float* __restrict__ g, const float* __restrict__ bta, float* __restrict__ out, int rows, int pad_) {
    const int row = blockIdx.x * 4 + (threadIdx.x >> 6), lane = threadIdx.x & 63; if (row >= rows) return;
    const float* r = in + (size_t)row * D; float v[16]; float s = 0.f;
#pragma unroll
    for (int j = 0; j < 16; ++j) { v[j] = r[lane + 64 * j]; s += v[j]; }
#pragma unroll
    for (int o = 32; o >= 1; o >>= 1) s += __shfl_xor(s, o);
    const float mean = s * (1.0f / D); float q = 0.f;
#pragma unroll
    for (int j = 0; j < 16; ++j) { v[j] -= mean; q += v[j] * v[j]; }
#pragma unroll
    for (int o = 32; o >= 1; o >>= 1) q += __shfl_xor(q, o);
    const float rstd = rsqrtf(q * (1.0f / D) + LN_EPS);
#pragma unroll
    for (int j = 0; j < 16; ++j) out[(size_t)row * D + lane + 64 * j] = v[j] * rstd * g[lane + 64 * j] + bta[lane + 64 * j];
}
__global__ __launch_bounds__(256) void xattn_k(const float* __restrict__ qc, const float* __restrict__ kc, const float* __restrict__ vc, float* __restrict__ oc) {
    const int w = blockIdx.x * 4 + (threadIdx.x >> 6), lane = threadIdx.x & 63; if (w >= T * NCH) return;
    const int h = w % NCH, tok = w / NCH, b = tok / SEQ;
    const float4 q = *(const float4*)(qc + (size_t)tok * D + h * CHD + lane * 4);
    float m = -INFINITY, l = 0.f; float4 acc = make_float4(0.f, 0.f, 0.f, 0.f);
    for (int mm = 0; mm < NMEM; ++mm) {
        const float4 k = *(const float4*)(kc + (size_t)(b * NMEM + mm) * D + h * CHD + lane * 4);
        float s = q.x * k.x + q.y * k.y + q.z * k.z + q.w * k.w;
#pragma unroll
        for (int o = 32; o >= 1; o >>= 1) s += __shfl_xor(s, o);
        if (s > m) { const float sc = expf(m - s); l *= sc; acc.x *= sc; acc.y *= sc; acc.z *= sc; acc.w *= sc; m = s; }
        const float p = expf(s - m); l += p;
        const float4 v = *(const float4*)(vc + (size_t)(b * NMEM + mm) * D + h * CHD + lane * 4);
        acc.x = fmaf(p, v.x, acc.x); acc.y = fmaf(p, v.y, acc.y); acc.z = fmaf(p, v.z, acc.z); acc.w = fmaf(p, v.w, acc.w);
    }
    const float il = 1.0f / l;
    *(float4*)(oc + (size_t)tok * D + h * CHD + lane * 4) = make_float4(acc.x * il, acc.y * il, acc.z * il, acc.w * il);
}
__global__ void topk_k(const float* __restrict__ logits, int* __restrict__ tidx, float* __restrict__ tgate, int* __restrict__ trank, int* __restrict__ cnt) {
    const int tok = blockIdx.x * blockDim.x + threadIdx.x; if (tok >= T) return;
    float lg[NE];
#pragma unroll
    for (int e = 0; e < NE; ++e) lg[e] = logits[(size_t)tok * NE + e];
    unsigned used = 0; float tv[4]; int ti[4];
#pragma unroll
    for (int k = 0; k < 4; ++k) { float best = -INFINITY; int bi = 0;
#pragma unroll
        for (int e = 0; e < NE; ++e) { const bool ok = !((used >> e) & 1u) && lg[e] > best; best = ok ? lg[e] : best; bi = ok ? e : bi; }
        used |= 1u << bi; tv[k] = best; ti[k] = bi; }
    const float mx = tv[0]; float ex[4], s = 0.f;
#pragma unroll
    for (int k = 0; k < 4; ++k) { ex[k] = expf(tv[k] - mx); s += ex[k]; }
#pragma unroll
    for (int k = 0; k < 4; ++k) { tidx[tok * 4 + k] = ti[k]; tgate[tok * 4 + k] = ex[k] / s; trank[tok * 4 + k] = atomicAdd(cnt + ti[k], 1); }
}
__global__ void offs_k(const int* __restrict__ cnt, int* __restrict__ off, int* __restrict__ tile_e, int ntiles, int pad_) {
    if (threadIdx.x != 0 || blockIdx.x != 0) return;
    int o = 0, tl = 0;
    for (int e = 0; e < NE; ++e) { off[e] = o; const int nt = (cnt[e] + 63) / 64; for (int i = 0; i < nt; ++i) tile_e[tl++] = e; o += nt * 64; }
    for (; tl < ntiles; ++tl) tile_e[tl] = -1;
}
__global__ void fill_k(const int* __restrict__ tidx, const float* __restrict__ tgate, const int* __restrict__ trank, const int* __restrict__ off,
                       int* __restrict__ slot_tok, float* __restrict__ slot_gate) {
    const int a = blockIdx.x * blockDim.x + threadIdx.x; if (a >= NASSIGN) return;
    const int slot = off[tidx[a]] + trank[a]; slot_tok[slot] = a >> 2; slot_gate[slot] = tgate[a];
}
__global__ void scale_k(const float* __restrict__ in, float* __restrict__ out, size_t n, float s, int pad_) {
    const size_t i = (size_t)blockIdx.x * blockDim.x + threadIdx.x; if (i < n) out[i] = in[i] * s;
}
}

constexpr size_t MiB = 1u << 20;
constexpr int MAXSLOT = NASSIGN + NE * 63, MAXTILES = (MAXSLOT + 63) / 64;
extern "C" void kernel_launch(void* const* d_in, const int* in_sizes, int n_in, void* d_out, int out_size, void* d_ws, size_t ws_size, hipStream_t stream) {
    const float* x = (const float*)d_in[0]; const float* mem = (const float*)d_in[1]; const int* pos = (const int*)d_in[2];
    const float* w_in = (const float*)d_in[3]; const float* sinks = (const float*)d_in[4]; const float* w_attn_o = (const float*)d_in[5];
    const float* lam_re = (const float*)d_in[6]; const float* lam_im = (const float*)d_in[7]; const float* log_dt = (const float*)d_in[8];
    const float* b_re = (const float*)d_in[9]; const float* b_im = (const float*)d_in[10]; const float* c_re = (const float*)d_in[11]; const float* c_im = (const float*)d_in[12];
    const float* d_skip = (const float*)d_in[13]; const float* w_glu_a = (const float*)d_in[14]; const float* w_glu_b = (const float*)d_in[15];
    const float* w_out = (const float*)d_in[16]; const float* ln1_g = (const float*)d_in[17]; const float* ln1_b = (const float*)d_in[18];
    const float* wq_c = (const float*)d_in[19]; const float* wk_c = (const float*)d_in[20]; const float* wv_c = (const float*)d_in[21]; const float* wo_c = (const float*)d_in[22];
    const float* ln2_g = (const float*)d_in[23]; const float* ln2_b = (const float*)d_in[24];
    const float* w_router = (const float*)d_in[25]; const float* b_router = (const float*)d_in[26];
    const float* w_gate_up = (const float*)d_in[27]; const float* b_gate_up = (const float*)d_in[28];
    const float* w_down = (const float*)d_in[29]; const float* b_down = (const float*)d_in[30];
    const float* ln3_g = (const float*)d_in[31]; const float* ln3_b = (const float*)d_in[32];
    float* out = (float*)d_out;
    char* ws = (char*)d_ws;
    int* cnt = (int*)(ws + 0);
    int* off = (int*)(ws + 4096);
    int* tile_e = (int*)(ws + 8192);
    float* abar = (float*)(ws + 1 * MiB);
    float* bbar = (float*)(ws + 1 * MiB + 65536);
    int* tidx = (int*)(ws + 2 * MiB); float* tgate = (float*)(ws + 3 * MiB); int* trank = (int*)(ws + 4 * MiB);
    int* slot_tok = (int*)(ws + 5 * MiB); float* slot_gate = (float*)(ws + 6 * MiB);
    float* logits = (float*)(ws + 8 * MiB);
    float* P = (float*)(ws + 16 * MiB);
    float* A1 = (float*)(ws + 496 * MiB);
    float* A2 = (float*)(ws + 624 * MiB);
    float* A3 = (float*)(ws + 688 * MiB);
    float* A4 = (float*)(ws + 816 * MiB);
    const dim3 blk(256);
    hipLaunchKernelGGL((nv::sgemm<nv::EpiStore>), dim3(INW / 64, T / 64), blk, 0, stream, x, nullptr, w_in, nullptr, (size_t)0, D, INW, T, INW, D, 0, nv::EpiStore{P, INW, 0});
    hipLaunchKernelGGL(nv::rope_k, dim3((unsigned)(((size_t)T * 18 * 32 + 255) / 256)), blk, 0, stream, P, pos);
    hipLaunchKernelGGL(nv::swa_k, dim3(T * NQH / 64), dim3(64), 0, stream, P, sinks, A1);
    hipLaunchKernelGGL(nv::ssm_pre_k, dim3(8), blk, 0, stream, lam_re, lam_im, log_dt, b_re, b_im, abar, bbar);
    hipLaunchKernelGGL(nv::ssm_scan_k, dim3(BATCH * SSM_G), dim3(64), 0, stream, P, abar, bbar, c_re, c_im, d_skip, A2);
    hipLaunchKernelGGL((nv::sgemm<nv::EpiStore>), dim3(D / 64, T / 64), blk, 0, stream, A1, nullptr, w_attn_o, nullptr, (size_t)0, QW, D, T, D, QW, 0, nv::EpiStore{A3, D, 0});
    hipLaunchKernelGGL((nv::sgemm<nv::EpiStore>), dim3(D / 64, T / 64), blk, 0, stream, A2, nullptr, w_glu_a, nullptr, (size_t)0, SSMW, D, T, D, SSMW, 0, nv::EpiStore{A1, D, 0});
    hipLaunchKernelGGL((nv::sgemm<nv::EpiMix>), dim3(D / 64, T / 64), blk, 0, stream, A2, nullptr, w_glu_b, nullptr, (size_t)0, SSMW, D, T, D, SSMW, 0, nv::EpiMix{A3, A1, P});
    float* pre = P; float* x1 = P + (size_t)T * D; float* qc = P + (size_t)2 * T * D;
    hipLaunchKernelGGL((nv::sgemm<nv::EpiResid>), dim3(D / 64, T / 64), blk, 0, stream, A3, nullptr, w_out, nullptr, (size_t)0, D, D, T, D, D, 0, nv::EpiResid{pre, x});
    hipLaunchKernelGGL(nv::ln_k, dim3(T / 4), blk, 0, stream, pre, ln1_g, ln1_b, x1, T, 0);
    float* kc = A2; float* vc = A2 + (size_t)BATCH * NMEM * D; float* oc = A1;
    hipLaunchKernelGGL((nv::sgemm<nv::EpiStoreScale>), dim3(D / 64, T / 64), blk, 0, stream, x1, nullptr, wq_c, nullptr, (size_t)0, D, D, T, D, D, 0, nv::EpiStoreScale{qc, D, 0.0625f});
    hipLaunchKernelGGL((nv::sgemm<nv::EpiStore>), dim3(D / 64, BATCH * NMEM / 64), blk, 0, stream, mem, nullptr, wk_c, nullptr, (size_t)0, D, D, BATCH * NMEM, D, D, 0, nv::EpiStore{kc, D, 0});
    hipLaunchKernelGGL((nv::sgemm<nv::EpiStore>), dim3(D / 64, BATCH * NMEM / 64), blk, 0, stream, mem, nullptr, wv_c, nullptr, (size_t)0, D, D, BATCH * NMEM, D, D, 0, nv::EpiStore{vc, D, 0});
    hipLaunchKernelGGL(nv::xattn_k, dim3(T * NCH / 4), blk, 0, stream, qc, kc, vc, oc);
    hipLaunchKernelGGL((nv::sgemm<nv::EpiResid>), dim3(D / 64, T / 64), blk, 0, stream, oc, nullptr, wo_c, nullptr, (size_t)0, D, D, T, D, D, 0, nv::EpiResid{pre, x1});
    float* x2 = A3;
    hipLaunchKernelGGL(nv::ln_k, dim3(T / 4), blk, 0, stream, pre, ln2_g, ln2_b, x2, T, 0);
    (void)hipMemsetAsync(cnt, 0, 4096, stream);
    (void)hipMemsetAsync(slot_tok, 0, 2 * MiB, stream);
    hipLaunchKernelGGL((nv::sgemm<nv::EpiBias>), dim3(1, T / 64), blk, 0, stream, x2, nullptr, w_router, nullptr, (size_t)0, D, NE, T, NE, D, 0, nv::EpiBias{logits, b_router, NE, NE});
    hipLaunchKernelGGL(nv::topk_k, dim3(T / 256), blk, 0, stream, logits, tidx, tgate, trank, cnt);
    hipLaunchKernelGGL(nv::offs_k, dim3(1), dim3(64), 0, stream, cnt, off, tile_e, MAXTILES, 0);
    hipLaunchKernelGGL(nv::fill_k, dim3(NASSIGN / 256), blk, 0, stream, tidx, tgate, trank, off, slot_tok, slot_gate);
    float* H = P; float* pre3 = A4;
    hipLaunchKernelGGL((nv::sgemm<nv::EpiSwiglu>), dim3(2 * DE / 64, MAXTILES), blk, 0, stream, x2, slot_tok, w_gate_up, tile_e, (size_t)D * 2 * DE, D, 2 * DE, MAXSLOT, 2 * DE, D, 0, nv::EpiSwiglu{H, b_gate_up});
    hipLaunchKernelGGL(nv::scale_k, dim3((unsigned)(((size_t)T * D + 255) / 256)), blk, 0, stream, x2, pre3, (size_t)T * D, ALPHA, 0);
    hipLaunchKernelGGL((nv::sgemm<nv::EpiDown>), dim3(D / 64, MAXTILES), blk, 0, stream, H, nullptr, w_down, tile_e, (size_t)DE * D, DE, D, MAXSLOT, D, DE, 0, nv::EpiDown{pre3, b_down, slot_tok, slot_gate});
    hipLaunchKernelGGL(nv::ln_k, dim3(T / 4), blk, 0, stream, pre3, ln3_g, ln3_b, out, T, 0);
}
```

```cpp
#include <hip/hip_runtime.h>
#include <cstdio>
#include <cstdint>
#include <cmath>

constexpr int BATCH = 16, SEQ = 2048, D = 1024, T = BATCH * SEQ;
constexpr int NQH = 16, NKVH = 2, HD = 64, WINDOW = 128;
constexpr int QW = 1024, KVW = 128, SSMW = 512, SSM_G = 32, SSM_H = 16, SSM_P = 64;
constexpr int INW = QW + 2 * KVW + SSMW + 2 * D;
constexpr int O_K = QW, O_V = O_K + KVW, O_S = O_V + KVW, O_GA = O_S + SSMW, O_GS = O_GA + D;
constexpr int NMEM = 256, NCH = 4, CHD = 256;
constexpr int NE = 32, TOPK = 4, DE = 1024;
constexpr float LN_EPS = 1e-5f;
constexpr float ALPHA = 1.189207115002721f;
constexpr int NASSIGN = T * TOPK;

namespace nv {
template <class Epi>
__global__ __launch_bounds__(256) void sgemm(const float* __restrict__ A, const int* __restrict__ ridx,
                                             const float* __restrict__ B, const int* __restrict__ tile_e, size_t bstride,
                                             int lda, int ldb, int M, int N, int K, int pad_, Epi epi) {
    __shared__ float As[16][68];
    __shared__ float Bs[16][68];
    const int tid = threadIdx.x, tx = tid & 15, ty = tid >> 4;
    const int m0 = blockIdx.y * 64, n0 = blockIdx.x * 64;
    int e = 0;
    if (tile_e) { e = tile_e[blockIdx.y]; if (e < 0) return; }
    const float* Bp = B + (size_t)e * bstride;
    float acc[4][4];
#pragma unroll
    for (int i = 0; i < 4; ++i)
#pragma unroll
        for (int j = 0; j < 4; ++j) acc[i][j] = 0.f;
    const int arow = tid >> 2, akq = (tid & 3) * 4;
    long asrc = -1;
    if (m0 + arow < M) { int r = m0 + arow; if (ridx) r = ridx[r]; asrc = (long)r * lda; }
    const int brow = tid >> 4, bcol = (tid & 15) * 4;
    for (int k0 = 0; k0 < K; k0 += 16) {
        float4 a = make_float4(0.f, 0.f, 0.f, 0.f);
        if (asrc >= 0) a = *(const float4*)(A + asrc + k0 + akq);
        As[akq + 0][arow] = a.x; As[akq + 1][arow] = a.y; As[akq + 2][arow] = a.z; As[akq + 3][arow] = a.w;
        float4 b = make_float4(0.f, 0.f, 0.f, 0.f);
        if (n0 + bcol < N) b = *(const float4*)(Bp + (size_t)(k0 + brow) * ldb + n0 + bcol);
        Bs[brow][bcol + 0] = b.x; Bs[brow][bcol + 1] = b.y; Bs[brow][bcol + 2] = b.z; Bs[brow][bcol + 3] = b.w;
        __syncthreads();
#pragma unroll
        for (int kk = 0; kk < 16; ++kk) {
            float av[4], bv[4];
#pragma unroll
            for (int i = 0; i < 4; ++i) av[i] = As[kk][ty * 4 + i];
#pragma unroll
            for (int j = 0; j < 4; ++j) bv[j] = Bs[kk][tx * 4 + j];
#pragma unroll
            for (int i = 0; i < 4; ++i)
#pragma unroll
                for (int j = 0; j < 4; ++j) acc[i][j] = fmaf(av[i], bv[j], acc[i][j]);
        }
        __syncthreads();
    }
#pragma unroll
    for (int i = 0; i < 4; ++i) {
        const int r = m0 + ty * 4 + i;
        if (r < M && n0 + tx * 4 < N) epi(r, n0 + tx * 4, acc[i], e);
    }
}

struct EpiStore { float* C; int ldc; int pad_;
    __device__ void operator()(int r, int c, const float (&v)[4], int) const { *(float4*)(C + (size_t)r * ldc + c) = make_float4(v[0], v[1], v[2], v[3]); } };
struct EpiStoreScale { float* C; int ldc; float s;
    __device__ void operator()(int r, int c, const float (&v)[4], int) const { *(float4*)(C + (size_t)r * ldc + c) = make_float4(v[0] * s, v[1] * s, v[2] * s, v[3] * s); } };
__device__ __forceinline__ float sigmoidf_(float x) { return 1.f / (1.f + expf(-x)); }
struct EpiMix { float* attn_out; const float* glu_a; const float* proj;
    __device__ void operator()(int r, int c, const float (&v)[4], int) const {
#pragma unroll
        for (int j = 0; j < 4; ++j) { const size_t o = (size_t)r * D + c + j;
            const float ga = sigmoidf_(proj[(size_t)r * INW + O_GA + c + j]), gs = sigmoidf_(proj[(size_t)r * INW + O_GS + c + j]);
            attn_out[o] = ga * attn_out[o] + gs * (glu_a[o] * sigmoidf_(v[j])); } } };
struct EpiResid { float* C; const float* res;
    __device__ void operator()(int r, int c, const float (&v)[4], int) const {
#pragma unroll
        for (int j = 0; j < 4; ++j) { const size_t o = (size_t)r * D + c + j; C[o] = ALPHA * res[o] + v[j]; } } };
struct EpiBias { float* C; const float* bias; int ldc; int N;
    __device__ void operator()(int r, int c, const float (&v)[4], int) const {
#pragma unroll
        for (int j = 0; j < 4; ++j) if (c + j < N) C[(size_t)r * ldc + c + j] = v[j] + bias[c + j]; } };
struct EpiSwiglu { float* H; const float* bgu;
    __device__ void operator()(int r, int c, const float (&v)[4], int e) const {
#pragma unroll
        for (int j = 0; j < 2; ++j) {
            float g = v[2 * j] + bgu[(size_t)e * 2 * DE + c + 2 * j], l = v[2 * j + 1] + bgu[(size_t)e * 2 * DE + c + 2 * j + 1];
            g = fminf(g, 7.0f); l = fminf(fmaxf(l, -7.0f), 7.0f);
            H[(size_t)r * DE + (c >> 1) + j] = g * sigmoidf_(1.702f * g) * (l + 1.0f); } } };
struct EpiDown { float* pre3; const float* bd; const int* slot_tok; const float* slot_gate;
    __device__ void operator()(int r, int c, const float (&v)[4], int e) const {
        const float g = slot_gate[r]; if (g == 0.f) return; const int tok = slot_tok[r];
#pragma unroll
        for (int j = 0; j < 4; ++j) atomicAdd(pre3 + (size_t)tok * D + c + j, (v[j] + bd[(size_t)e * D + c + j]) * g); } };

__global__ void rope_k(float* proj, const int* pos) {
    const size_t gid = (size_t)blockIdx.x * blockDim.x + threadIdx.x;
    if (gid >= (size_t)T * 18 * 32) return;
    const int i = gid & 31; const int hh = (gid >> 5) % 18; const size_t tok = gid / (18 * 32);
    const float inv = powf(10000.0f, -(float)i / 32.0f);
    const float ang = (float)pos[tok] * inv; const float c = cosf(ang), s = sinf(ang);
    float* p = proj + tok * INW + (hh < 16 ? hh * 64 : O_K + (hh - 16) * 64);
    const float t1 = p[i], t2 = p[i + 32];
    p[i] = t1 * c - t2 * s; p[i + 32] = t2 * c + t1 * s;
}
__global__ __launch_bounds__(64) void swa_k(const float* __restrict__ proj, const float* __restrict__ sinks, float* __restrict__ out) {
    const int gid = blockIdx.x * blockDim.x + threadIdx.x;
    if (gid >= T * NQH) return;
    const int hq = gid % NQH, tok = gid / NQH, t = tok % SEQ, b = tok / SEQ, kvh = hq / 8;
    float q[64], acc[64];
    const float* qp = proj + (size_t)tok * INW + hq * 64;
#pragma unroll
    for (int d = 0; d < 64; ++d) { q[d] = qp[d] * 0.125f; acc[d] = 0.f; }
    float m = sinks[hq], l = 1.0f;
    const int k0 = t - (WINDOW - 1) < 0 ? 0 : t - (WINDOW - 1);
    for (int kp = k0; kp <= t; ++kp) {
        const float* kr = proj + (size_t)(b * SEQ + kp) * INW + O_K + kvh * 64;
        const float* vr = proj + (size_t)(b * SEQ + kp) * INW + O_V + kvh * 64;
        float s = 0.f;
#pragma unroll
        for (int d = 0; d < 64; ++d) s = fmaf(q[d], kr[d], s);
        if (s > m) { const float sc = expf(m - s); l *= sc;
#pragma unroll
            for (int d = 0; d < 64; ++d) acc[d] *= sc;
            m = s; }
        const float p = expf(s - m); l += p;
#pragma unroll
        for (int d = 0; d < 64; ++d) acc[d] = fmaf(p, vr[d], acc[d]);
    }
    const float il = 1.0f / l;
    float* op = out + (size_t)tok * QW + hq * 64;
#pragma unroll
    for (int d = 0; d < 64; ++d) op[d] = acc[d] * il;
}
__global__ void ssm_pre_k(const float* lam_re, const float* lam_im, const float* log_dt, const float* b_re, const float* b_im,
                          float* abar, float* bbar) {
    const int gp = blockIdx.x * blockDim.x + threadIdx.x; if (gp >= SSM_G * SSM_P) return;
    const int g = gp / SSM_P;
    const float lr = lam_re[gp], li = lam_im[gp], dt = expf(log_dt[g]);
    const float mag = expf(lr * dt), ar = mag * cosf(li * dt), ai = mag * sinf(li * dt);
    const float den = lr * lr + li * li;
    const float fr = ((ar - 1.0f) * lr + ai * li) / den, fi = (ai * lr - (ar - 1.0f) * li) / den;
    abar[gp * 2] = ar; abar[gp * 2 + 1] = ai;
    for (int h = 0; h < 16; ++h) { const float br = b_re[gp * 16 + h], bi = b_im[gp * 16 + h];
        bbar[(gp * 2) * 16 + h] = fr * br - fi * bi; bbar[(gp * 2 + 1) * 16 + h] = fr * bi + fi * br; }
}
__device__ __forceinline__ float gelu_tanh(float x) { return 0.5f * x * (1.0f + tanhf(0.7978845608028654f * (x + 0.044715f * x * x * x))); }
__global__ __launch_bounds__(64) void ssm_scan_k(const float* __restrict__ proj, const float* __restrict__ abar, const float* __restrict__ bbar,
                                                 const float* __restrict__ c_re, const float* __restrict__ c_im, const float* __restrict__ d_skip, float* __restrict__ z) {
    const int g = blockIdx.x % SSM_G, b = blockIdx.x / SSM_G, p = threadIdx.x, gp = g * SSM_P + p;
    const float ar = abar[gp * 2], ai = abar[gp * 2 + 1];
    float br[16], bi[16], cr[16], ci[16];
#pragma unroll
    for (int h = 0; h < 16; ++h) { br[h] = bbar[(gp * 2) * 16 + h]; bi[h] = bbar[(gp * 2 + 1) * 16 + h];
        cr[h] = c_re[(g * 16 + h) * SSM_P + p]; ci[h] = c_im[(g * 16 + h) * SSM_P + p]; }
    const float dsk = p < 16 ? d_skip[g * 16 + p] : 0.f;
    const int pu = p < 16 ? p : 0;
    float hr = 0.f, hi = 0.f;
    for (int t = 0; t < SEQ; ++t) {
        const float* up = proj + (size_t)(b * SEQ + t) * INW + O_S + g * 16;
        float u[16];
#pragma unroll
        for (int h = 0; h < 16; ++h) u[h] = up[h];
        float bur = 0.f, bui = 0.f;
#pragma unroll
        for (int h = 0; h < 16; ++h) { bur = fmaf(br[h], u[h], bur); bui = fmaf(bi[h], u[h], bui); }
        const float nr = ar * hr - ai * hi + bur, ni = ar * hi + ai * hr + bui; hr = nr; hi = ni;
        float mine = 0.f;
#pragma unroll
        for (int h = 0; h < 16; ++h) { float v = cr[h] * hr - ci[h] * hi;
#pragma unroll
            for (int o = 32; o >= 1; o >>= 1) v += __shfl_xor(v, o);
            if (p == h) mine = v; }
        const float uown = up[pu];
        if (p < 16) { const float y = mine + dsk * uown; z[(size_t)(b * SEQ + t) * SSMW + g * 16 + p] = gelu_tanh(y); }
    }
}
__global__ __launch_bounds__(256) void ln_k(const float* __restrict__ in, const float* __restrict__ g, const float* __restrict__ bta, float* __restrict__ out, int rows, int pad_) {
    const int row = blockIdx.x * 4 + (threadIdx.x >> 6), lane = threadIdx.x & 63; if (row >= rows) return;
    const float* r = in + (size_t)row * D; float v[16]; float s = 0.f;
#pragma unroll
    for (int j = 0; j < 16; ++j) { v[j] = r[lane + 64 * j]; s += v[j]; }
#pragma unroll
    for (int o = 32; o >= 1; o >>= 1) s += __shfl_xor(s, o);
    const float mean = s * (1.0f / D); float q = 0.f;
#pragma unroll
    for (int j = 0; j < 16; ++j) { v[j] -= mean; q += v[j] * v[j]; }
#pragma unroll
    for (int o = 32; o >= 1; o >>= 1) q += __shfl_xor(q, o);
    const float rstd = rsqrtf(q * (1.0f / D) + LN_EPS);
#pragma unroll
    for (int j = 0; j < 16; ++j) out[(size_t)row * D + lane + 64 * j] = v[j] * rstd * g[lane + 64 * j] + bta[lane + 64 * j];
}
__global__ __launch_bounds__(256) void xattn_k(const float* __restrict__ qc, const float* __restrict__ kc, const float* __restrict__ vc, float* __restrict__ oc) {
    const int w = blockIdx.x * 4 + (threadIdx.x >> 6), lane = threadIdx.x & 63; if (w >= T * NCH) return;
    const int h = w % NCH, tok = w / NCH, b = tok / SEQ;
    const float4 q = *(const float4*)(qc + (size_t)tok * D + h * CHD + lane * 4);
    float m = -INFINITY, l = 0.f; float4 acc = make_float4(0.f, 0.f, 0.f, 0.f);
    for (int mm = 0; mm < NMEM; ++mm) {
        const float4 k = *(const float4*)(kc + (size_t)(b * NMEM + mm) * D + h * CHD + lane * 4);
        float s = q.x * k.x + q.y * k.y + q.z * k.z + q.w * k.w;
#pragma unroll
        for (int o = 32; o >= 1; o >>= 1) s += __shfl_xor(s, o);
        if (s > m) { const float sc = expf(m - s); l *= sc; acc.x *= sc; acc.y *= sc; acc.z *= sc; acc.w *= sc; m = s; }
        const float p = expf(s - m); l += p;
        const float4 v = *(const float4*)(vc + (size_t)(b * NMEM + mm) * D + h * CHD + lane * 4);
        acc.x = fmaf(p, v.x, acc.x); acc.y = fmaf(p, v.y, acc.y); acc.z = fmaf(p, v.z, acc.z); acc.w = fmaf(p, v.w, acc.w);
    }
    const float il = 1.0f / l;
    *(float4*)(oc + (size_t)tok * D + h * CHD + lane * 4) = make_float4(acc.x * il, acc.y * il, acc.z * il, acc.w * il);
}
__global__ void topk_k(const float* __restrict__ logits, int* __restrict__ tidx, float* __restrict__ tgate, int* __restrict__ trank, int* __restrict__ cnt) {
    const int tok = blockIdx.x * blockDim.x + threadIdx.x; if (tok >= T) return;
    float lg[NE];
#pragma unroll
    for (int e = 0; e < NE; ++e) lg[e] = logits[(size_t)tok * NE + e];
    unsigned used = 0; float tv[4]; int ti[4];
#pragma unroll
    for (int k = 0; k < 4; ++k) { float best = -INFINITY; int bi = 0;
#pragma unroll
        for (int e = 0; e < NE; ++e) { const bool ok = !((used >> e) & 1u) && lg[e] > best; best = ok ? lg[e] : best; bi = ok ? e : bi; }
        used |= 1u << bi; tv[k] = best; ti[k] = bi; }
    const float mx = tv[0]; float ex[4], s = 0.f;
#pragma unroll
    for (int k = 0; k < 4; ++k) { ex[k] = expf(tv[k] - mx); s += ex[k]; }
#pragma unroll
    for (int k = 0; k < 4; ++k) { tidx[tok * 4 + k] = ti[k]; tgate[tok * 4 + k] = ex[k] / s; trank[tok * 4 + k] = atomicAdd(cnt + ti[k], 1); }
}
__global__ void offs_k(const int* __restrict__ cnt, int* __restrict__ off, int* __restrict__ tile_e, int ntiles, int pad_) {
    if (threadIdx.x != 0 || blockIdx.x != 0) return;
    int o = 0, tl = 0;
    for (int e = 0; e < NE; ++e) { off[e] = o; const int nt = (cnt[e] + 63) / 64; for (int i = 0; i < nt; ++i) tile_e[tl++] = e; o += nt * 64; }
    for (; tl < ntiles; ++tl) tile_e[tl] = -1;
}
__global__ void fill_k(const int* __restrict__ tidx, const float* __restrict__ tgate, const int* __restrict__ trank, const int* __restrict__ off,
                       int* __restrict__ slot_tok, float* __restrict__ slot_gate) {
    const int a = blockIdx.x * blockDim.x + threadIdx.x; if (a >= NASSIGN) return;
    const int slot = off[tidx[a]] + trank[a]; slot_tok[slot] = a >> 2; slot_gate[slot] = tgate[a];
}
__global__ void scale_k(const float* __restrict__ in, float* __restrict__ out, size_t n, float s, int pad_) {
    const size_t i = (size_t)blockIdx.x * blockDim.x + threadIdx.x; if (i < n) out[i] = in[i] * s;
}
}


#define GAS __attribute__((address_space(1)))
#define LAS __attribute__((address_space(3)))
typedef unsigned short bf16;
typedef unsigned v4u __attribute__((ext_vector_type(4)));
typedef unsigned v2u __attribute__((ext_vector_type(2)));
typedef float f32x4 __attribute__((ext_vector_type(4)));
typedef float f32x2 __attribute__((ext_vector_type(2)));
typedef float f32x16 __attribute__((ext_vector_type(16)));
typedef short bf16x8 __attribute__((ext_vector_type(8)));
typedef GAS unsigned gu32;
#define RLX_AGENT __ATOMIC_RELAXED, __HIP_MEMORY_SCOPE_AGENT
#define LDS_WAIT() asm volatile("s_waitcnt lgkmcnt(0)" ::: "memory")
#define VM_WAIT() asm volatile("s_waitcnt vmcnt(0)" ::: "memory")

typedef __bf16 bf16x2_t __attribute__((ext_vector_type(2)));
__device__ __forceinline__ unsigned cvt_pk_bf16(float lo, float hi) { const f32x2 v = {lo, hi}; const bf16x2_t b = __builtin_convertvector(v, bf16x2_t); return __builtin_bit_cast(unsigned, b); }
__device__ __forceinline__ float bf_lo(unsigned w) { return __uint_as_float(w << 16); }
__device__ __forceinline__ float bf_hi(unsigned w) { return __uint_as_float(w & 0xffff0000u); }
__device__ __forceinline__ float fast_sigmoid(float x) { return __builtin_amdgcn_rcpf(1.0f + __builtin_amdgcn_exp2f(-1.4426950408889634f * x)); }
__device__ __forceinline__ int lane_id_v() { int l; asm volatile("v_mbcnt_lo_u32_b32 %0, -1, 0\n\tv_mbcnt_hi_u32_b32 %0, -1, %0" : "=v"(l)); return l; }
__device__ __forceinline__ float wave_sum(float v) {
#pragma unroll
    for (int o = 1; o < 64; o <<= 1) v += __shfl_xor(v, o);
    return v;
}

namespace pg8 {
constexpr int BM = 256, BK = 64, HALF = 128, HTB = HALF * BK * 2  , STAGE_BYTES = 8 * HTB;
__host__ __device__ __forceinline__ int lds_byte(int r, int c) { const int st = (r >> 4) * 2 + (c >> 5), rr = r & 15, cc = c & 31, ob = rr * 64 + cc * 2; return st * 1024 + (ob ^ (((ob >> 9) & 1) << 5)); }
__host__ __device__ __forceinline__ void stage_rc(int b, int& R, int& C) { const int st = b / 1024, sb = b % 1024, swz = sb ^ (((sb >> 9) & 1) << 5); R = (st >> 1) * 16 + swz / 64; C = (st & 1) * 32 + (swz % 64) / 2; }
__host__ __device__ __forceinline__ int perm32(int rho) { const int n = rho >> 4, i = rho & 15; return 8 * (i >> 2) + 4 * n + (i & 3); }

struct Unit { const char* A; const char* B; int pm, pn, aux, aux2; };
struct Gemm { int lda, ldb, K; };

template <class Epi, class Sched, bool ALIGN_EPI = true, bool SP2 = true>
__device__ __forceinline__ void gemm_phase(LAS unsigned char* lds, const Gemm g, const Sched& S, const Epi& E, int wid) {
    const int lane = lane_id_v(), tid = wid * 64 + lane, wr = wid >> 2, wc = wid & 3, fr = lane & 15, fq = lane >> 4;
    int K = g.K; asm volatile("" : "+s"(K));
    const int nt = K / BK;
    unsigned voffA[2], voffB[2];
#pragma unroll
    for (int i = 0; i < 2; ++i) { int R, C; stage_rc(tid * 16 + i * 8192, R, C);
        voffA[i] = (unsigned)(R * g.lda + C * 2); voffB[i] = (unsigned)(R * g.ldb + C * 2); }
    const size_t kstep = (size_t)(BK * 2);
    const size_t hstepA = (size_t)HALF * g.lda, hstepB = (size_t)HALF * g.ldb;
    const unsigned ldsw = (unsigned)wid * 1024u;
    const int aoff = lds_byte(wr * 64 + fr, fq * 8), boff = lds_byte(wc * 32 + fr, fq * 8);
#define PG8_SA(b, h) (((b) * 2 + (h)) * HTB)
#define PG8_SB(b, h) ((4 + (b) * 2 + (h)) * HTB)
#define PG8_STAGE(bufoff, gbase, voff) do { _Pragma("unroll") for (int _i = 0; _i < 2; ++_i) \
        __builtin_amdgcn_global_load_lds((const unsigned*)((const char*)(gbase) + (voff)[_i]), (LAS unsigned*)(lds + (bufoff) + ldsw + _i * 8192), 16, 0, 0); } while (0)
#define PG8_LDA(dst, b, h) do { _Pragma("unroll") for (int m = 0; m < 4; ++m) _Pragma("unroll") for (int k = 0; k < 2; ++k) dst[m][k] = *(const LAS bf16x8*)(lds + PG8_SA(b, h) + aoff + m * 2048 + k * 1024); } while (0)
#define PG8_LDB(dst, b, h) do { _Pragma("unroll") for (int n = 0; n < 2; ++n) _Pragma("unroll") for (int k = 0; k < 2; ++k) dst[n][k] = *(const LAS bf16x8*)(lds + PG8_SB(b, h) + boff + n * 2048 + k * 1024); } while (0)
#define PG8_MMA(ai, bj, At, Bt) do { __builtin_amdgcn_s_setprio(1); _Pragma("unroll") for (int m = 0; m < 4; ++m) _Pragma("unroll") for (int n = 0; n < 2; ++n) _Pragma("unroll") for (int k = 0; k < 2; ++k) \
        acc[ai][bj][m][n] = __builtin_amdgcn_mfma_f32_16x16x32_bf16(Bt[n][k], At[m][k], acc[ai][bj][m][n], 0, 0, 0); __builtin_amdgcn_s_setprio(0); } while (0)
#define PG8_WAIT_V(n) asm volatile("s_waitcnt vmcnt(" #n ")" ::: "memory")
#define PG8_WAIT_L(n) asm volatile("s_waitcnt lgkmcnt(" #n ")" ::: "memory")
#define PG8_BAR __builtin_amdgcn_s_barrier()
#define PG8_SCHED __builtin_amdgcn_sched_barrier(0)
    Unit cur, nxt; int ui = 0;
    if (!S.next(0, cur)) return;
    f32x4 acc[2][2][4][2];
#pragma unroll
    for (int a = 0; a < 2; ++a)
#pragma unroll
        for (int b = 0; b < 2; ++b)
#pragma unroll
            for (int m = 0; m < 4; ++m)
#pragma unroll
                for (int n = 0; n < 2; ++n) acc[a][b][m][n] = (f32x4){0.f, 0.f, 0.f, 0.f};
    bf16x8 At[4][2], B0[2][2], B1[2][2];
    const char* cA = cur.A; const char* cB = cur.B;
    if constexpr (SP2) {
        PG8_STAGE(PG8_SB(0, 0), cB, voffB); PG8_STAGE(PG8_SB(0, 1), cB + hstepB, voffB); PG8_STAGE(PG8_SA(0, 0), cA, voffA); PG8_STAGE(PG8_SA(0, 1), cA + hstepA, voffA);
        if (wr == 1) PG8_BAR;
        PG8_WAIT_V(2); PG8_BAR;
        PG8_STAGE(PG8_SB(1, 0), cB + kstep, voffB); PG8_STAGE(PG8_SA(1, 0), cA + kstep, voffA); PG8_STAGE(PG8_SB(1, 1), cB + hstepB + kstep, voffB);
        PG8_WAIT_V(6); PG8_BAR;
    } else {
        PG8_STAGE(PG8_SB(0, 0), cB, voffB); PG8_STAGE(PG8_SA(0, 0), cA, voffA); PG8_STAGE(PG8_SB(0, 1), cB + hstepB, voffB); PG8_STAGE(PG8_SA(0, 1), cA + hstepA, voffA);
        if (wr == 1) PG8_BAR;
        PG8_WAIT_V(4); PG8_BAR;
        PG8_STAGE(PG8_SB(1, 0), cB + kstep, voffB); PG8_STAGE(PG8_SA(1, 0), cA + kstep, voffA); PG8_STAGE(PG8_SB(1, 1), cB + hstepB + kstep, voffB);
        PG8_WAIT_V(6); PG8_BAR;
    }
    for (;;) {
        const bool has_next = S.next(ui + 1, nxt);
        const char* nA = has_next ? nxt.A : cA; const char* nB = has_next ? nxt.B : cB;
        for (int t = 0; t < nt; t += 2) {
            const bool last = (t == nt - 2);
            const char* a1 = cA + (size_t)(t + 1) * kstep;
            const char* a2 = last ? nA : cA + (size_t)(t + 2) * kstep; const char* b2 = last ? nB : cB + (size_t)(t + 2) * kstep;
            const char* a3 = a2 + kstep; const char* b3 = b2 + kstep;
            if constexpr (SP2) {
            PG8_LDB(B0, 0, 0); PG8_LDB(B1, 0, 1); PG8_SCHED; PG8_LDA(At, 0, 0); PG8_STAGE(PG8_SA(1, 1), a1 + hstepA, voffA);
            PG8_WAIT_V(8); PG8_WAIT_L(0); PG8_BAR; PG8_MMA(0, 0, At, B0); PG8_MMA(0, 1, At, B1); PG8_BAR; PG8_SCHED;
            PG8_LDA(At, 0, 1); PG8_STAGE(PG8_SB(0, 0), b2, voffB); PG8_STAGE(PG8_SB(0, 1), b2 + hstepB, voffB); PG8_STAGE(PG8_SA(0, 0), a2, voffA);
            PG8_WAIT_V(8); PG8_WAIT_L(0); PG8_BAR; PG8_MMA(1, 0, At, B0); PG8_MMA(1, 1, At, B1); PG8_BAR; PG8_SCHED;
            PG8_LDB(B0, 1, 0); PG8_LDB(B1, 1, 1); PG8_SCHED; PG8_LDA(At, 1, 0); PG8_STAGE(PG8_SA(0, 1), a2 + hstepA, voffA);
            PG8_WAIT_V(8); PG8_WAIT_L(0); PG8_BAR; PG8_MMA(0, 0, At, B0); PG8_MMA(0, 1, At, B1); PG8_BAR; PG8_SCHED;
            PG8_LDA(At, 1, 1); PG8_STAGE(PG8_SB(1, 0), b3, voffB); PG8_STAGE(PG8_SB(1, 1), b3 + hstepB, voffB); PG8_STAGE(PG8_SA(1, 0), a3, voffA);
            PG8_WAIT_V(8); PG8_WAIT_L(0); PG8_BAR; PG8_MMA(1, 0, At, B0); PG8_MMA(1, 1, At, B1); PG8_BAR; PG8_SCHED;
            } else {
            PG8_LDB(B0, 0, 0); PG8_SCHED; PG8_LDA(At, 0, 0); PG8_STAGE(PG8_SA(1, 1), a1 + hstepA, voffA);
            PG8_WAIT_L(8); PG8_BAR; PG8_WAIT_L(0); PG8_MMA(0, 0, At, B0); PG8_BAR; PG8_SCHED;
            PG8_LDB(B1, 0, 1); PG8_STAGE(PG8_SB(0, 0), b2, voffB);
            PG8_BAR; PG8_WAIT_L(0); PG8_MMA(0, 1, At, B1); PG8_BAR;
            PG8_LDA(At, 0, 1); PG8_STAGE(PG8_SA(0, 0), a2, voffA);
            PG8_BAR; PG8_WAIT_L(0); PG8_MMA(1, 0, At, B0); PG8_BAR; PG8_SCHED;
            PG8_STAGE(PG8_SB(0, 1), b2 + hstepB, voffB);
            PG8_WAIT_V(6); PG8_BAR; PG8_MMA(1, 1, At, B1); PG8_BAR;
            PG8_LDB(B0, 1, 0); PG8_SCHED; PG8_LDA(At, 1, 0); PG8_STAGE(PG8_SA(0, 1), a2 + hstepA, voffA);
            PG8_WAIT_L(8); PG8_BAR; PG8_WAIT_L(0); PG8_MMA(0, 0, At, B0); PG8_BAR; PG8_SCHED;
            PG8_LDB(B1, 1, 1); PG8_STAGE(PG8_SB(1, 0), b3, voffB);
            PG8_BAR; PG8_WAIT_L(0); PG8_MMA(0, 1, At, B1); PG8_BAR;
            PG8_LDA(At, 1, 1); PG8_STAGE(PG8_SA(1, 0), a3, voffA);
            PG8_BAR; PG8_WAIT_L(0); PG8_MMA(1, 0, At, B0); PG8_BAR; PG8_SCHED;
            PG8_STAGE(PG8_SB(1, 1), b3 + hstepB, voffB);
            PG8_WAIT_V(6); PG8_BAR; PG8_MMA(1, 1, At, B1); PG8_BAR;
            }
        }
        if constexpr (ALIGN_EPI) { if (wr == 0) PG8_BAR; }
        E(acc, cur, wr, wc, fr, fq);
        if (!has_next) break;
#pragma unroll
        for (int a = 0; a < 2; ++a)
#pragma unroll
            for (int b = 0; b < 2; ++b)
#pragma unroll
                for (int m = 0; m < 4; ++m)
#pragma unroll
                    for (int n = 0; n < 2; ++n) acc[a][b][m][n] = (f32x4){0.f, 0.f, 0.f, 0.f};
        cur = nxt; cA = nA; cB = nB; ++ui;
        if constexpr (ALIGN_EPI) { if (wr == 1) PG8_BAR; }
    }
    PG8_WAIT_V(0);
    if constexpr (!ALIGN_EPI) { if (wr == 0) PG8_BAR; }
    PG8_BAR;
#undef PG8_SA
#undef PG8_SB
#undef PG8_STAGE
#undef PG8_LDA
#undef PG8_LDB
#undef PG8_MMA
#undef PG8_WAIT_V
#undef PG8_WAIT_L
#undef PG8_BAR
#undef PG8_SCHED
}
}

#define XB_TMO      128
#define XB_XCNT(j)  (256  + 64 * (j))
#define XB_XSUB(j)  (1280 + 64 * (j))
#define XB_XGEN(j)  (2304 + 64 * (j))
#define XB_TOP      3328
#define XB_TOPGEN   3392
#define XCD_BAR_WORDS 3456
#define XB_SPIN_CAP (1u << 18)
__device__ __forceinline__ unsigned xb_ld(unsigned* p)              { return __hip_atomic_load(p, __ATOMIC_RELAXED, __HIP_MEMORY_SCOPE_AGENT); }
__device__ __forceinline__ unsigned xb_add(unsigned* p, unsigned v) { return __hip_atomic_fetch_add(p, v, __ATOMIC_RELAXED, __HIP_MEMORY_SCOPE_AGENT); }
__device__ __forceinline__ unsigned xb_xcc_id() { return (unsigned)__builtin_amdgcn_s_getreg((3 << 11) | 20) & 0xFu; }
#define XB_SPIN(cond, bar) do { unsigned _sp = 0; while (cond) { __builtin_amdgcn_s_sleep(1); \
    if ((++_sp & 255u) == 0u) { if (xb_ld(&(bar)[XB_TMO])) break; if (_sp > XB_SPIN_CAP) { atomicAdd(&(bar)[XB_TMO], 1u); break; } } } } while (0)
struct XcdBarrier { unsigned* bar; unsigned x; volatile LAS unsigned* st; };
__device__ __forceinline__ XcdBarrier xcd_barrier_post(unsigned* bar, volatile LAS unsigned* st) {
    XcdBarrier b; b.bar = bar; b.x = xb_xcc_id(); b.st = st;
    if (threadIdx.x == 0) (void)xb_add(&bar[XB_XCNT(b.x)], 1u);
    return b;
}
__device__ __forceinline__ void xcd_barrier_complete(unsigned* bar, unsigned x, unsigned& nloc, unsigned& nx) {
    const unsigned G = gridDim.x * gridDim.y * gridDim.z;
    unsigned sum, cnt, mine, sp = 0u;
    for (;;) {
        sum = 0u; cnt = 0u; mine = 0u;
#pragma unroll
        for (unsigned j = 0; j < 16; ++j) { const unsigned c = xb_ld(&bar[XB_XCNT(j)]); sum += c; cnt += (c > 0u) ? 1u : 0u; mine = (j == x) ? c : mine; }
        if (sum == G) break;
        __builtin_amdgcn_s_sleep(1);
        if ((++sp & 255u) == 0u) { if (xb_ld(&bar[XB_TMO])) break; if (sp > XB_SPIN_CAP) { atomicAdd(&bar[XB_TMO], 1u); break; } }
    }
    nloc = mine > 0u ? mine : 1u; nx = cnt > 0u ? cnt : 1u;
}
__device__ __forceinline__ void xcd_barrier(const XcdBarrier& b, int wave) {
    asm volatile("s_waitcnt vmcnt(0)" ::: "memory");
    __syncthreads();
    if (wave == 0 && lane_id_v() == 0) {
        unsigned* bar = b.bar;
        __builtin_amdgcn_s_waitcnt(0);
        unsigned nloc = b.st[0], nx = b.st[1];
        if (nloc == 0u) { xcd_barrier_complete(bar, b.x, nloc, nx); b.st[0] = nloc; b.st[1] = nx; }
        const unsigned old = xb_add(&bar[XB_XSUB(b.x)], 1u);
        const unsigned gen = old / nloc;
        if (old + 1u == (gen + 1u) * nloc) {
            __builtin_amdgcn_fence(__ATOMIC_RELEASE, "agent");
            asm volatile("s_waitcnt vmcnt(0)" ::: "memory");
            const unsigned og = xb_add(&bar[XB_TOP], 1u);
            const unsigned tg = og / nx;
            if (og + 1u == (tg + 1u) * nx) xb_add(&bar[XB_TOPGEN], 1u);
            else XB_SPIN(xb_ld(&bar[XB_TOPGEN]) == tg, bar);
            __builtin_amdgcn_fence(__ATOMIC_ACQUIRE, "agent");
            xb_add(&bar[XB_XGEN(b.x)], 1u);
            asm volatile("s_waitcnt vmcnt(0)" ::: "memory");
        } else {
            XB_SPIN(xb_ld(&bar[XB_XGEN(b.x)]) == gen, bar);
            __builtin_amdgcn_fence(__ATOMIC_ACQUIRE, "agent");
            asm volatile("s_waitcnt vmcnt(0)" ::: "memory");
        }
    }
    __syncthreads();
}

constexpr size_t MiB = 1u << 20;
constexpr size_t WS_CTL = 0, CTL_ZERO_BYTES = 1 * MiB;
constexpr int CW_TMO = 0, CW_BAR = 4096, CW_CNT = 16384;
constexpr size_t WS_TIDX = 1 * MiB, WS_TGATE = 2 * MiB, WS_TRANK = 3 * MiB, WS_TOKSLOT = 4 * MiB, WS_SLOTGATE = 5 * MiB, WS_WGBASE = 6 * MiB;
constexpr size_t WS_WRF = 7 * MiB;
constexpr size_t WS_WGU = 16 * MiB;
constexpr size_t WS_WD = 144 * MiB;
constexpr size_t WS_WMISC = 208 * MiB;
constexpr size_t WS_RA = 272 * MiB, WS_RB = 544 * MiB, WS_RC = 816 * MiB, WS_RD = 944 * MiB, WS_END = 1024 * MiB;
constexpr size_t WS_WQ = WS_WMISC + 0 * MiB, WS_WK = WS_WMISC + 2 * MiB, WS_WV = WS_WMISC + 4 * MiB, WS_WOC = WS_WMISC + 6 * MiB;
constexpr size_t WS_X1 = WS_RA, WS_X1B = WS_RA + 128 * MiB, WS_QC = WS_RA + 192 * MiB;
constexpr size_t WS_PRE1 = WS_RB, WS_PM = WS_RB, WS_OC = WS_RB + 64 * MiB, WS_PRE2 = WS_RB + 128 * MiB;
constexpr size_t WS_X2 = WS_RC;
constexpr size_t WS_MEMB = WS_RD, WS_KC = WS_RD + 8 * MiB, WS_VCT = WS_RD + 16 * MiB;
constexpr size_t WS_WIN = WS_WMISC + 8 * MiB, WS_WAO = WS_WMISC + 16 * MiB, WS_WGLU = WS_WMISC + 18 * MiB, WS_WOUT = WS_WMISC + 20 * MiB,
                 WS_BTS = WS_WMISC + 22 * MiB  , WS_BTST = WS_WMISC + 42 * MiB  , WS_ABARL = WS_WMISC + 50 * MiB;
constexpr size_t WS_XB = WS_RA, WS_QR = WS_RA + 64 * MiB, WS_MIX = WS_RA + 192 * MiB;
constexpr size_t WS_GA = WS_RB, WS_GS = WS_RB + 64 * MiB, WS_AO = WS_RB + 128 * MiB, WS_SG = WS_RB + 192 * MiB, WS_SST = WS_RB + 256 * MiB;
constexpr size_t WS_AS = WS_RC, WS_Z = WS_RC + 40 * MiB, WS_KR = WS_RC + 72 * MiB, WS_VR = WS_RC + 80 * MiB, WS_CS = WS_RC + 88 * MiB;
constexpr int MAXTILE256 = (NASSIGN + NE * 255) / 256 + 1;

constexpr int RING_BYTES = 131072, MISC_OFF = RING_BYTES, LDS_BYTES = 147456;
constexpr int NWAVES = 8;

struct Args {
    const float* in[33]; float* out; unsigned char* ws;
    unsigned long long mask;
};

__host__ __device__ __forceinline__ int sigma32(int q) { return 16 * ((q >> 2) & 1) + 4 * (q >> 3) + (q & 3); }
template <class PermFn, bool KSIG = false>
__device__ __forceinline__ void transpose_item(const float* W, int K, int N, bf16* WT, LAS float* scr, int item, int lane, const PermFn& perm) {
    const int nblk = N / 32, kb = item / nblk, nb = item % nblk, k0 = 64 * kb, n0 = 32 * nb;
#pragma unroll 8
    for (int i = 0; i < 32; ++i) { const int kk = 2 * i + (lane >> 5); const int ks = KSIG ? ((kk & 32) + sigma32(kk & 31)) : kk;
        scr[kk * 33 + (lane & 31)] = W[(size_t)(k0 + ks) * N + n0 + (lane & 31)]; }
    LDS_WAIT(); asm volatile("" ::: "memory");
    const int c = lane & 7;
#pragma unroll
    for (int j = 0; j < 4; ++j) { const int n = (lane >> 3) + 8 * j; const LAS float* s = scr + (8 * c) * 33 + n;
        v4u o; o.x = cvt_pk_bf16(s[0 * 33], s[1 * 33]); o.y = cvt_pk_bf16(s[2 * 33], s[3 * 33]); o.z = cvt_pk_bf16(s[4 * 33], s[5 * 33]); o.w = cvt_pk_bf16(s[6 * 33], s[7 * 33]);
        *(GAS v4u*)(WT + (size_t)perm(n0 + n) * K + k0 + 8 * c) = o; }
    LDS_WAIT(); asm volatile("" ::: "memory");
}
struct PermId { __device__ __forceinline__ int operator()(int n) const { return n; } };
struct PermGU { __device__ __forceinline__ int operator()(int n) const { const int ty = n & 1, lc = n >> 1, pn = lc >> 7, wc = (lc >> 5) & 3, fq = (lc >> 3) & 3, bj = (lc >> 2) & 1, j = lc & 3;
    return 256 * pn + 128 * bj + 32 * wc + 16 * ty + 4 * fq + j; } };

__device__ __forceinline__ int crow32(int r, int hi) { return (r & 3) + 8 * (r >> 2) + 4 * hi; }
__device__ __forceinline__ void phase_router(const Args& a, LAS unsigned char* lds, int wave) {
    unsigned char* ws = a.ws; const int lane = lane_id_v(), tid = wave * 64 + lane;
    LAS int* hist = (LAS int*)(lds + 65536);
    LAS float* tile = (LAS float*)(lds + wave * 8192);
    if (tid < 32) hist[tid] = 0;
    __syncthreads();
    if (wave < 4) {
        const int tok0 = (blockIdx.x * 4 + wave) * 32, r32 = lane & 31, hi = lane >> 5;
        const float* xr = (const float*)(ws + WS_X2) + (size_t)(tok0 + r32) * D + hi * 8;
        const bf16x8* wh = (const bf16x8*)(ws + WS_WRF) + hi * 32 + r32;
        const bf16x8* wl = (const bf16x8*)(ws + WS_WRF + 65536) + hi * 32 + r32;
        f32x16 acc;
#pragma unroll
        for (int r = 0; r < 16; ++r) acc[r] = 0.f;
#pragma unroll 2
        for (int s = 0; s < 64; ++s) {
            const f32x4 v0 = *(const f32x4*)(xr + s * 16), v1 = *(const f32x4*)(xr + s * 16 + 4);
            v4u h, l;
            h.x = cvt_pk_bf16(v0[0], v0[1]); h.y = cvt_pk_bf16(v0[2], v0[3]); h.z = cvt_pk_bf16(v1[0], v1[1]); h.w = cvt_pk_bf16(v1[2], v1[3]);
            l.x = cvt_pk_bf16(v0[0] - bf_lo(h.x), v0[1] - bf_hi(h.x)); l.y = cvt_pk_bf16(v0[2] - bf_lo(h.y), v0[3] - bf_hi(h.y));
            l.z = cvt_pk_bf16(v1[0] - bf_lo(h.z), v1[1] - bf_hi(h.z)); l.w = cvt_pk_bf16(v1[2] - bf_lo(h.w), v1[3] - bf_hi(h.w));
            const bf16x8 ah = __builtin_bit_cast(bf16x8, h), al = __builtin_bit_cast(bf16x8, l);
            const bf16x8 bh = wh[s * 64], bl = wl[s * 64];
            acc = __builtin_amdgcn_mfma_f32_32x32x16_bf16(ah, bh, acc, 0, 0, 0);
            acc = __builtin_amdgcn_mfma_f32_32x32x16_bf16(ah, bl, acc, 0, 0, 0);
            acc = __builtin_amdgcn_mfma_f32_32x32x16_bf16(al, bh, acc, 0, 0, 0);
        }
        const float bias = a.in[26][r32];
#pragma unroll
        for (int r = 0; r < 16; ++r) tile[crow32(r, hi) * 33 + r32] = acc[r] + bias;
        LDS_WAIT(); asm volatile("" ::: "memory");
        if (lane < 32) {
            float lg[NE];
#pragma unroll
            for (int e = 0; e < NE; ++e) lg[e] = tile[lane * 33 + e];
            unsigned used = 0; float tv[4]; int ti[4];
#pragma unroll
            for (int k = 0; k < 4; ++k) { float best = -INFINITY; int bi = 0;
#pragma unroll
                for (int e = 0; e < NE; ++e) { const bool ok = !((used >> e) & 1u) && lg[e] > best; best = ok ? lg[e] : best; bi = ok ? e : bi; }
                used |= 1u << bi; tv[k] = best; ti[k] = bi; }
            float ex[4], s = 0.f;
#pragma unroll
            for (int k = 0; k < 4; ++k) { ex[k] = __expf(tv[k] - tv[0]); s += ex[k]; }
            const float is = 1.0f / s; int rk[4];
#pragma unroll
            for (int k = 0; k < 4; ++k) rk[k] = __hip_atomic_fetch_add(hist + ti[k], 1, __ATOMIC_RELAXED, __HIP_MEMORY_SCOPE_WORKGROUP);
            const int tok = tok0 + lane;
            *(int4*)(ws + WS_TIDX + (size_t)tok * 16) = make_int4(ti[0], ti[1], ti[2], ti[3]);
            *(float4*)(ws + WS_TGATE + (size_t)tok * 16) = make_float4(ex[0] * is, ex[1] * is, ex[2] * is, ex[3] * is);
            *(int4*)(ws + WS_TRANK + (size_t)tok * 16) = make_int4(rk[0], rk[1], rk[2], rk[3]);
        }
    }
    __syncthreads();
    if (tid < 32) { const int base = (int)__hip_atomic_fetch_add((unsigned*)(ws + WS_CTL) + CW_CNT + tid, (unsigned)hist[tid], RLX_AGENT);
        ((int*)(ws + WS_WGBASE))[blockIdx.x * 32 + tid] = base; }
}

__device__ __forceinline__ int expert_tiles(const Args& a, int lane, int& start_tile) {
    const int c = lane < 32 ? (int)__hip_atomic_load((unsigned*)(a.ws + WS_CTL) + CW_CNT + lane, RLX_AGENT) : 0;
    const int tiles = (c + 255) >> 8; int incl = tiles;
#pragma unroll
    for (int o = 1; o < 64; o <<= 1) { const int t = __shfl_up(incl, o); if (lane >= o) incl += t; }
    start_tile = incl - tiles;
    return __shfl(incl, 63);
}

__device__ __forceinline__ void phase_slots(const Args& a, int wave) {
    unsigned char* ws = a.ws; const int lane = lane_id_v(), tid = wave * 64 + lane;
    int start_tile; (void)expert_tiles(a, lane, start_tile);
    const int p = blockIdx.x * 512 + tid;
    const int e = ((const int*)(ws + WS_TIDX))[p], rank = ((const int*)(ws + WS_TRANK))[p]; const float gate = ((const float*)(ws + WS_TGATE))[p];
    const int st = __shfl(start_tile, e) * 256, base = ((const int*)(ws + WS_WGBASE))[blockIdx.x * 32 + e];
    const int slot = st + base + rank;
    ((int*)(ws + WS_TOKSLOT))[p] = slot; ((float*)(ws + WS_SLOTGATE))[slot] = gate;
    bf16* XG = (bf16*)(ws + WS_RA);
    for (int q = 0; q < 64; ++q) {
        const int s = __shfl(slot, q), tok = blockIdx.x * 128 + ((wave * 64 + q) >> 2);
        const float* src = (const float*)(ws + WS_X2) + (size_t)tok * D + lane * 8;
#pragma unroll
        for (int hh = 0; hh < 2; ++hh) { const f32x4 v0 = *(const f32x4*)(src + hh * 512), v1 = *(const f32x4*)(src + hh * 512 + 4);
            v4u o; o.x = cvt_pk_bf16(v0[0], v0[1]); o.y = cvt_pk_bf16(v0[2], v0[3]); o.z = cvt_pk_bf16(v1[0], v1[1]); o.w = cvt_pk_bf16(v1[2], v1[3]);
            *(GAS v4u*)(XG + (size_t)s * D + hh * 512 + lane * 8) = o; }
    }
}

struct MoeOrder {
    int stl, ntot, sh, G, c; const char* A; const char* B; size_t a_tile, b_tile, b_exp;
    __device__ __forceinline__ bool next(int i, pg8::Unit& u) const {
        const int L = i * G + c; if (L >= (ntot << sh)) return false;
        const int rt = L >> sh, pn = L & ((1 << sh) - 1);
        const int e = __popcll(__ballot(stl <= rt)) - 1;
        u.A = A + (size_t)rt * a_tile; u.B = B + (size_t)e * b_exp + (size_t)pn * b_tile; u.pm = rt; u.pn = pn; u.aux = e; u.aux2 = 0; return true;
    }
};
struct EpiSwigluB {
    bf16* H; const float* bgu;
    __device__ __forceinline__ void operator()(const f32x4 (&acc)[2][2][4][2], const pg8::Unit& u, int wr, int wc, int fr, int fq) const {
        const int row0 = u.pm * 256 + wr * 64 + fr, lc0 = u.pn * 128 + wc * 32 + fq * 8;
        const float* bp = bgu + (size_t)u.aux * (2 * DE) + 2 * lc0;
        f32x4 b4[4];
#pragma unroll
        for (int i = 0; i < 4; ++i) b4[i] = *(const f32x4*)(bp + 4 * i);
#pragma unroll
        for (int ai = 0; ai < 2; ++ai)
#pragma unroll
            for (int m = 0; m < 4; ++m) {
                float hv[8];
#pragma unroll
                for (int bj = 0; bj < 2; ++bj)
#pragma unroll
                    for (int j = 0; j < 4; ++j) {
                        float g = acc[ai][bj][m][0][j] + b4[2 * bj + (j >> 1)][2 * (j & 1)], l = acc[ai][bj][m][1][j] + b4[2 * bj + (j >> 1)][2 * (j & 1) + 1];
                        g = fminf(g, 7.0f); l = fminf(fmaxf(l, -7.0f), 7.0f);
                        hv[4 * bj + j] = g * fast_sigmoid(1.702f * g) * (l + 1.0f); }
                v4u o; o.x = cvt_pk_bf16(hv[0], hv[1]); o.y = cvt_pk_bf16(hv[2], hv[3]); o.z = cvt_pk_bf16(hv[4], hv[5]); o.w = cvt_pk_bf16(hv[6], hv[7]);
                *(GAS v4u*)(H + (size_t)(row0 + ai * 128 + m * 16) * DE + lc0) = o; }
    }
};
struct EpiDownB {
    bf16* Y; const float* bd; const float* slot_gate;
    __device__ __forceinline__ void operator()(const f32x4 (&acc)[2][2][4][2], const pg8::Unit& u, int wr, int wc, int fr, int fq) const {
        const int row0 = u.pm * 256 + wr * 64 + fr, col0 = u.pn * 256 + wc * 32 + fq * 4;
        f32x4 bv[2][2];
#pragma unroll
        for (int bj = 0; bj < 2; ++bj)
#pragma unroll
            for (int n = 0; n < 2; ++n) bv[bj][n] = *(const f32x4*)(bd + (size_t)u.aux * D + col0 + bj * 128 + n * 16);
#pragma unroll
        for (int ai = 0; ai < 2; ++ai)
#pragma unroll
            for (int m = 0; m < 4; ++m) { const int row = row0 + ai * 128 + m * 16; const float gt = slot_gate[row];
#pragma unroll
                for (int bj = 0; bj < 2; ++bj)
#pragma unroll
                    for (int n = 0; n < 2; ++n) { const f32x4 v = (acc[ai][bj][m][n] + bv[bj][n]) * gt;
                        v2u o; o.x = cvt_pk_bf16(v[0], v[1]); o.y = cvt_pk_bf16(v[2], v[3]);
                        *(GAS v2u*)(Y + (size_t)row * D + col0 + bj * 128 + n * 16) = o; } }
    }
};

__device__ __forceinline__ void phase_combine(const Args& a, int wave) {
    unsigned char* ws = a.ws; const int lane = lane_id_v(); const bf16* Y = (const bf16*)(ws + WS_RA);
    const float* g3 = a.in[31]; const float* b3 = a.in[32];
    for (int tok = blockIdx.x * NWAVES + wave; tok < T; tok += gridDim.x * NWAVES) {
        const int myslot = ((const int*)(ws + WS_TOKSLOT))[tok * 4 + (lane & 3)];
        int sl[4];
#pragma unroll
        for (int k = 0; k < 4; ++k) sl[k] = __shfl(myslot, k);
        f32x4 v[4]; float s = 0.f;
#pragma unroll
        for (int j = 0; j < 4; ++j) { v[j] = *(const f32x4*)((const float*)(ws + WS_X2) + (size_t)tok * D + 4 * (64 * j + lane)) * ALPHA;
#pragma unroll
            for (int k = 0; k < 4; ++k) { const v2u w = *(const GAS v2u*)(Y + (size_t)sl[k] * D + 4 * (64 * j + lane));
                v[j][0] += bf_lo(w.x); v[j][1] += bf_hi(w.x); v[j][2] += bf_lo(w.y); v[j][3] += bf_hi(w.y); }
            s += (v[j][0] + v[j][1]) + (v[j][2] + v[j][3]); }
        const float mean = wave_sum(s) * (1.0f / D); float q = 0.f;
#pragma unroll
        for (int j = 0; j < 4; ++j) { v[j] = v[j] - mean; q += (v[j][0] * v[j][0] + v[j][1] * v[j][1]) + (v[j][2] * v[j][2] + v[j][3] * v[j][3]); }
        const float rstd = rsqrtf(wave_sum(q) * (1.0f / D) + LN_EPS);
#pragma unroll
        for (int j = 0; j < 4; ++j) { const int c = 4 * (64 * j + lane); const f32x4 gg = *(const f32x4*)(g3 + c), bb = *(const f32x4*)(b3 + c);
            *(f32x4*)(a.out + (size_t)tok * D + c) = v[j] * rstd * gg + bb; }
    }
}


struct GridOrder {
    int nM, nN, nwg, G, c; const char* A; const char* B; size_t a_tile, b_tile;
    __device__ __forceinline__ bool next(int i, pg8::Unit& u) const {
        const int L = i * G + c; if (L >= nwg) return false;
        int wgid = L; { const int q = nwg / 8, r = nwg % 8, xcd = wgid % 8, off = wgid / 8; wgid = (xcd < r ? xcd * (q + 1) : r * (q + 1) + (xcd - r) * q) + off; }
        const int nig = 8 * nN, gid = wgid / nig, fm = gid * 8, gsz = (nM - fm) < 8 ? (nM - fm) : 8;
        const int pm = fm + ((wgid % nig) % gsz), pn = (wgid % nig) / gsz;
        u.A = A + (size_t)pm * a_tile; u.B = B + (size_t)pn * b_tile; u.pm = pm; u.pn = pn; u.aux = 0; u.aux2 = 0; return true;
    }
};
__device__ __forceinline__ GridOrder grid_order(int M, int N, int rot, const void* A, size_t lda_b, const void* B, size_t ldb_b) {
    GridOrder S; S.nM = M / 256; S.nN = N / 256; S.nwg = S.nM * S.nN; S.G = (int)gridDim.x; S.c = (int)((blockIdx.x + (unsigned)rot) % gridDim.x);
    S.A = (const char*)A; S.B = (const char*)B; S.a_tile = 256 * lda_b; S.b_tile = 256 * ldb_b; return S;
}
struct BhOrder {
    int G, c; const char* A; const char* B; size_t a_b, a_rt, a_h, b_b, b_h;
    __device__ __forceinline__ bool next(int i, pg8::Unit& u) const {
        const int L = i * G + c; if (L >= BATCH * NCH * (SEQ / 256)) return false;
        const int b = L >> 5, h = (L >> 3) & 3, rt = L & 7;
        u.A = A + (size_t)b * a_b + (size_t)rt * a_rt + (size_t)h * a_h; u.B = B + (size_t)b * b_b + (size_t)h * b_h; u.pm = b * 8 + rt; u.pn = h; u.aux = 0; u.aux2 = 0; return true;
    }
};
struct EpiBf16N8 {
    bf16* O; int ldo; float scale;
    __device__ __forceinline__ void operator()(const f32x4 (&acc)[2][2][4][2], const pg8::Unit& u, int wr, int wc, int fr, int fq) const {
        const int row0 = u.pm * 256 + wr * 64 + fr, col0 = u.pn * 256 + wc * 32 + fq * 8;
#pragma unroll
        for (int ai = 0; ai < 2; ++ai)
#pragma unroll
            for (int m = 0; m < 4; ++m) { bf16* rowp = O + (size_t)(row0 + ai * 128 + m * 16) * ldo + col0;
#pragma unroll
                for (int bj = 0; bj < 2; ++bj) { const f32x4 v0 = acc[ai][bj][m][0] * scale, v1 = acc[ai][bj][m][1] * scale;
                    v4u w; w.x = cvt_pk_bf16(v0[0], v0[1]); w.y = cvt_pk_bf16(v0[2], v0[3]); w.z = cvt_pk_bf16(v1[0], v1[1]); w.w = cvt_pk_bf16(v1[2], v1[3]);
                    *(GAS v4u*)(rowp + bj * 128) = w; } }
    }
};
struct EpiResF32 {
    float* C; const float* res;
    __device__ __forceinline__ void operator()(const f32x4 (&acc)[2][2][4][2], const pg8::Unit& u, int wr, int wc, int fr, int fq) const {
        const int row0 = u.pm * 256 + wr * 64 + fr, col0 = u.pn * 256 + wc * 32 + fq * 4;
#pragma unroll
        for (int ai = 0; ai < 2; ++ai)
#pragma unroll
            for (int m = 0; m < 4; ++m) { const size_t ro = (size_t)(row0 + ai * 128 + m * 16) * D + col0;
#pragma unroll
                for (int bj = 0; bj < 2; ++bj)
#pragma unroll
                    for (int n = 0; n < 2; ++n) { const size_t o = ro + bj * 128 + n * 16; const f32x4 r = *(const f32x4*)(res + o);
                        *(f32x4*)(C + o) = r * ALPHA + acc[ai][bj][m][n]; } }
    }
};
struct EpiSoftmax {
    bf16* O; int ldo; LAS f32x2* X;
    __device__ __forceinline__ void operator()(f32x4 (&acc)[2][2][4][2], const pg8::Unit& u, int wr, int wc, int fr_, int fq_) const {
        const int l_ = lane_id_v(), fr = l_ & 15, fq = l_ >> 4;
#pragma unroll
        for (int ai = 0; ai < 2; ++ai)
#pragma unroll
            for (int m = 0; m < 4; ++m) {
                float mx = -INFINITY;
#pragma unroll
                for (int bj = 0; bj < 2; ++bj)
#pragma unroll
                    for (int n = 0; n < 2; ++n)
#pragma unroll
                        for (int j = 0; j < 4; ++j) mx = fmaxf(mx, acc[ai][bj][m][n][j]);
                mx = fmaxf(mx, __shfl_xor(mx, 16)); mx = fmaxf(mx, __shfl_xor(mx, 32));
                float s = 0.f;
#pragma unroll
                for (int bj = 0; bj < 2; ++bj)
#pragma unroll
                    for (int n = 0; n < 2; ++n)
#pragma unroll
                        for (int j = 0; j < 4; ++j) { const float p = __builtin_amdgcn_exp2f((acc[ai][bj][m][n][j] - mx) * 1.4426950408889634f); acc[ai][bj][m][n][j] = p; s += p; }
                s += __shfl_xor(s, 16); s += __shfl_xor(s, 32);
                if (fq == 0) X[(ai * 128 + wr * 64 + m * 16 + fr) * 4 + wc] = (f32x2){mx, s};
                __builtin_amdgcn_sched_barrier(0);
            }
        LDS_WAIT(); __builtin_amdgcn_s_barrier(); asm volatile("" ::: "memory");
        const int row0 = u.pm * 256 + wr * 64 + fr, col0 = u.pn * 256 + wc * 32 + fq * 8;
#pragma unroll
        for (int ai = 0; ai < 2; ++ai)
#pragma unroll
            for (int m = 0; m < 4; ++m) {
                const int rl = ai * 128 + wr * 64 + m * 16 + fr;
                const f32x2 x0 = X[rl * 4 + 0], x1 = X[rl * 4 + 1], x2 = X[rl * 4 + 2], x3 = X[rl * 4 + 3];
                const float M = fmaxf(fmaxf(x0.x, x1.x), fmaxf(x2.x, x3.x));
                const float L = x0.y * __builtin_amdgcn_exp2f((x0.x - M) * 1.4426950408889634f) + x1.y * __builtin_amdgcn_exp2f((x1.x - M) * 1.4426950408889634f)
                              + x2.y * __builtin_amdgcn_exp2f((x2.x - M) * 1.4426950408889634f) + x3.y * __builtin_amdgcn_exp2f((x3.x - M) * 1.4426950408889634f);
                const float mown = wc == 0 ? x0.x : wc == 1 ? x1.x : wc == 2 ? x2.x : x3.x;
                const float sc = __builtin_amdgcn_exp2f((mown - M) * 1.4426950408889634f) / L;
                bf16* rowp = O + (size_t)(row0 + ai * 128 + m * 16) * ldo + col0;
#pragma unroll
                for (int bj = 0; bj < 2; ++bj) { const f32x4 v0 = acc[ai][bj][m][0] * sc, v1 = acc[ai][bj][m][1] * sc;
                    v4u w; w.x = cvt_pk_bf16(v0[0], v0[1]); w.y = cvt_pk_bf16(v0[2], v0[3]); w.z = cvt_pk_bf16(v1[0], v1[1]); w.w = cvt_pk_bf16(v1[2], v1[3]);
                    *(GAS v4u*)(rowp + bj * 128) = w; }
                __builtin_amdgcn_sched_barrier(0); }
        LDS_WAIT();
    }
};

__device__ __forceinline__ void phase_ln(const float* pre, const float* gam, const float* bet, float* outf, bf16* outb, int wave) {
    const int lane = lane_id_v();
    for (int row = blockIdx.x * NWAVES + wave; row < T; row += gridDim.x * NWAVES) {
        f32x4 v[4]; float s = 0.f;
#pragma unroll
        for (int j = 0; j < 4; ++j) { v[j] = *(const f32x4*)(pre + (size_t)row * D + 4 * (64 * j + lane)); s += (v[j][0] + v[j][1]) + (v[j][2] + v[j][3]); }
        const float mean = wave_sum(s) * (1.0f / D); float q = 0.f;
#pragma unroll
        for (int j = 0; j < 4; ++j) { v[j] = v[j] - mean; q += (v[j][0] * v[j][0] + v[j][1] * v[j][1]) + (v[j][2] * v[j][2] + v[j][3] * v[j][3]); }
        const float rstd = rsqrtf(wave_sum(q) * (1.0f / D) + LN_EPS);
#pragma unroll
        for (int j = 0; j < 4; ++j) { const int c = 4 * (64 * j + lane); const f32x4 gg = *(const f32x4*)(gam + c), bb = *(const f32x4*)(bet + c);
            const f32x4 o = v[j] * rstd * gg + bb;
            if (outf) *(f32x4*)(outf + (size_t)row * D + c) = o;
            if (outb) { v2u w; w.x = cvt_pk_bf16(o[0], o[1]); w.y = cvt_pk_bf16(o[2], o[3]); *(GAS v2u*)(outb + (size_t)row * D + c) = w; } }
    }
}
__device__ __forceinline__ void cvt_rows(const float* src, bf16* dst, size_t n, int lane, int wave) {
    const size_t stride = (size_t)gridDim.x * NWAVES * 64 * 8;
    for (size_t i = ((size_t)(blockIdx.x * NWAVES + wave) * 64 + lane) * 8; i < n; i += stride) {
        const f32x4 v0 = *(const f32x4*)(src + i), v1 = *(const f32x4*)(src + i + 4);
        v4u o; o.x = cvt_pk_bf16(v0[0], v0[1]); o.y = cvt_pk_bf16(v0[2], v0[3]); o.z = cvt_pk_bf16(v1[0], v1[1]); o.w = cvt_pk_bf16(v1[2], v1[3]);
        *(GAS v4u*)(dst + i) = o; }
}

constexpr float LOG2E = 1.4426950408889634f;
constexpr int SSM_L = 32, SSM_NCH = SEQ / SSM_L  , SSM_ROWS = BATCH * SSM_NCH  , SSM_K = SSM_L * SSM_H + 2 * SSM_P  ;

struct PermWin { __device__ __forceinline__ int operator()(int n) const { if (n >= O_V) return n; const int d = n & 63; return (n & ~63) + 2 * (d & 31) + (d >> 5); } };
template <int TY> struct PermGlu { __device__ __forceinline__ int operator()(int lc) const { const int pn = lc >> 7, wc = (lc >> 5) & 3, fq = (lc >> 3) & 3, bj = (lc >> 2) & 1, j = lc & 3;
    return 256 * pn + 128 * bj + 32 * wc + 16 * TY + 4 * fq + j; } };

__device__ __forceinline__ float gelu_tanh_f(float x) {
    const float u = 0.7978845608028654f * (x + 0.044715f * x * x * x);
    const float e = __builtin_amdgcn_exp2f(2.0f * LOG2E * u);
    return x * (1.0f - __builtin_amdgcn_rcpf(e + 1.0f));
}

struct EpiInproj {
    bf16 *QR, *KR, *VR, *AS, *GA, *GS; const float* cs;
    __device__ __forceinline__ static void rot(f32x4& v, const f32x4 c) { const float a0 = v[0] * c[0] - v[1] * c[1], a1 = v[1] * c[0] + v[0] * c[1], a2 = v[2] * c[2] - v[3] * c[3], a3 = v[3] * c[2] + v[2] * c[3]; v = (f32x4){a0, a1, a2, a3}; }
    __device__ __forceinline__ void operator()(const f32x4 (&acc)[2][2][4][2], const pg8::Unit& u, int wr, int wc, int fr, int fq) const {
        const int pn = u.pn, row0 = u.pm * 256 + wr * 64 + fr;
        if (pn < 5) {
            const float qs = pn < 4 ? 0.125f * LOG2E : 1.0f;
#pragma unroll
            for (int ai = 0; ai < 2; ++ai)
#pragma unroll
                for (int m = 0; m < 4; ++m) { const int row = row0 + ai * 128 + m * 16;
                    const float* cp = cs + (size_t)row * 64 + 2 * (16 * (wc & 1) + 2 * fq);
#pragma unroll
                    for (int bj = 0; bj < 2; ++bj) { f32x4 v0 = acc[ai][bj][m][0], v1 = acc[ai][bj][m][1];
                        const bool isv = (pn == 4) && (bj == 1);
                        if (!isv) { const f32x4 c0 = *(const f32x4*)cp, c1 = *(const f32x4*)(cp + 16); rot(v0, c0); rot(v1, c1); v0 = v0 * qs; v1 = v1 * qs; }
                        v4u w; w.x = cvt_pk_bf16(v0[0], v0[1]); w.y = cvt_pk_bf16(v0[2], v0[3]); w.z = cvt_pk_bf16(v1[0], v1[1]); w.w = cvt_pk_bf16(v1[2], v1[3]);
                        bf16* dst = pn < 4 ? QR + (size_t)row * QW + 256 * pn + 128 * bj + 32 * wc + 8 * fq : (bj == 0 ? KR : VR) + (size_t)row * KVW + 32 * wc + 8 * fq;
                        *(GAS v4u*)dst = w; } }
        } else if (pn < 7) {
#pragma unroll
            for (int ai = 0; ai < 2; ++ai)
#pragma unroll
                for (int m = 0; m < 4; ++m) { const int row = row0 + ai * 128 + m * 16, b = row >> 11, t = row & (SEQ - 1);
                    const size_t rbase = ((size_t)(b * SSM_NCH + (t >> 5)) * SSM_K + (t & 31) * 16 + 4 * fq);
#pragma unroll
                    for (int bj = 0; bj < 2; ++bj)
#pragma unroll
                        for (int n = 0; n < 2; ++n) { const int g = 16 * (pn - 5) + 8 * bj + 2 * wc + n; const f32x4 v = acc[ai][bj][m][n];
                            v2u w; w.x = cvt_pk_bf16(v[0], v[1]); w.y = cvt_pk_bf16(v[2], v[3]);
                            *(GAS v2u*)(AS + (size_t)g * SSM_ROWS * SSM_K + rbase) = w; } }
        } else {
            bf16* base = pn < 11 ? GA : GS; const int cb = 256 * ((pn - 7) & 3);
#pragma unroll
            for (int ai = 0; ai < 2; ++ai)
#pragma unroll
                for (int m = 0; m < 4; ++m) { const int row = row0 + ai * 128 + m * 16;
#pragma unroll
                    for (int bj = 0; bj < 2; ++bj) { const f32x4 v0 = acc[ai][bj][m][0], v1 = acc[ai][bj][m][1];
                        v4u w; w.x = cvt_pk_bf16(fast_sigmoid(v0[0]), fast_sigmoid(v0[1])); w.y = cvt_pk_bf16(fast_sigmoid(v0[2]), fast_sigmoid(v0[3]));
                        w.z = cvt_pk_bf16(fast_sigmoid(v1[0]), fast_sigmoid(v1[1])); w.w = cvt_pk_bf16(fast_sigmoid(v1[2]), fast_sigmoid(v1[3]));
                        *(GAS v4u*)(base + (size_t)row * D + cb + 128 * bj + 32 * wc + 8 * fq) = w; } }
        }
    }
};

constexpr int AT_KSTR = 144, AT_VSTR = 328, AT_VOFF = 160 * AT_KSTR;
__device__ __forceinline__ void phase_attn(const Args& a, LAS unsigned char* lds, int wave, const bf16* QR, const bf16* KR, const bf16* VR, bf16* AO) {
    const int lane = lane_id_v(), tid = wave * 64 + lane, r32 = lane & 31, hi = lane >> 5;
    const int nunits = BATCH * NKVH * (SEQ / 32);
    for (int L = blockIdx.x; L < nunits; L += gridDim.x) {
        const int b = L >> 7, kvh = (L >> 6) & 1, q0 = (L & 63) * 32;
        const size_t tok0 = (size_t)b * SEQ;
        for (int c = tid; c < 160 * 8; c += NWAVES * 64) {
            const int key = c >> 3, ch = c & 7, kpos = q0 - 128 + key, kp = kpos < 0 ? 0 : kpos;
            const v4u kv = *(const GAS v4u*)(KR + (tok0 + kp) * KVW + kvh * 64 + ch * 8);
            const v4u vv = *(const GAS v4u*)(VR + (tok0 + kp) * KVW + kvh * 64 + ch * 8);
            *(LAS v4u*)(lds + key * AT_KSTR + ch * 16) = kv;
            LAS bf16* vt = (LAS bf16*)(lds + AT_VOFF + (ch * 8) * AT_VSTR + key * 2);
            vt[0 * (AT_VSTR / 2)] = (bf16)(vv.x & 0xffffu); vt[1 * (AT_VSTR / 2)] = (bf16)(vv.x >> 16);
            vt[2 * (AT_VSTR / 2)] = (bf16)(vv.y & 0xffffu); vt[3 * (AT_VSTR / 2)] = (bf16)(vv.y >> 16);
            vt[4 * (AT_VSTR / 2)] = (bf16)(vv.z & 0xffffu); vt[5 * (AT_VSTR / 2)] = (bf16)(vv.z >> 16);
            vt[6 * (AT_VSTR / 2)] = (bf16)(vv.w & 0xffffu); vt[7 * (AT_VSTR / 2)] = (bf16)(vv.w >> 16);
        }
        const int hq = kvh * 8 + wave;
        bf16x8 qf[4];
#pragma unroll
        for (int s = 0; s < 4; ++s) qf[s] = *(const bf16x8*)(QR + (tok0 + q0 + r32) * QW + hq * 64 + s * 16 + hi * 8);
        __syncthreads();
        f32x16 sc[5];
#pragma unroll
        for (int kb = 0; kb < 5; ++kb) {
            f32x16 acc;
#pragma unroll
            for (int r = 0; r < 16; ++r) acc[r] = 0.f;
#pragma unroll
            for (int s = 0; s < 4; ++s) { const bf16x8 kf = *(const LAS bf16x8*)(lds + (kb * 32 + r32) * AT_KSTR + (s * 16 + hi * 8) * 2);
                acc = __builtin_amdgcn_mfma_f32_32x32x16_bf16(kf, qf[s], acc, 0, 0, 0); }
            sc[kb] = acc;
        }
        const float sink = a.in[4][hq] * LOG2E;
        float mx = sink;
        const int kmin = 128 - q0;
#pragma unroll
        for (int kb = 0; kb < 5; ++kb)
#pragma unroll
            for (int r = 0; r < 16; ++r) { const int key = kb * 32 + (r & 3) + 8 * (r >> 2) + 4 * hi;
                bool ok = key >= kmin; if (kb == 0) ok = ok && (key > r32); if (kb == 4) ok = ok && (key - 128 <= r32);
                const float s = ok ? sc[kb][r] : -INFINITY; sc[kb][r] = s; mx = fmaxf(mx, s); }
        mx = fmaxf(mx, __shfl_xor(mx, 32));
        float ls = 0.f;
#pragma unroll
        for (int kb = 0; kb < 5; ++kb)
#pragma unroll
            for (int r = 0; r < 16; ++r) { const float p = __builtin_amdgcn_exp2f(sc[kb][r] - mx); sc[kb][r] = p; ls += p; }
        ls += __shfl_xor(ls, 32);
        ls += __builtin_amdgcn_exp2f(sink - mx);
        f32x16 o[2];
#pragma unroll
        for (int r = 0; r < 16; ++r) { o[0][r] = 0.f; o[1][r] = 0.f; }
#pragma unroll
        for (int kb = 0; kb < 5; ++kb)
#pragma unroll
            for (int s2 = 0; s2 < 2; ++s2) {
                v4u pk; pk.x = cvt_pk_bf16(sc[kb][8 * s2 + 0], sc[kb][8 * s2 + 1]); pk.y = cvt_pk_bf16(sc[kb][8 * s2 + 2], sc[kb][8 * s2 + 3]);
                pk.z = cvt_pk_bf16(sc[kb][8 * s2 + 4], sc[kb][8 * s2 + 5]); pk.w = cvt_pk_bf16(sc[kb][8 * s2 + 6], sc[kb][8 * s2 + 7]);
                const bf16x8 pf = __builtin_bit_cast(bf16x8, pk);
#pragma unroll
                for (int db = 0; db < 2; ++db) { const LAS unsigned char* vp = lds + AT_VOFF + (db * 32 + r32) * AT_VSTR + (kb * 32 + 16 * s2 + 4 * hi) * 2;
                    const v2u lo = *(const LAS v2u*)vp, hh = *(const LAS v2u*)(vp + 16);
                    const v4u av = {lo.x, lo.y, hh.x, hh.y};
                    o[db] = __builtin_amdgcn_mfma_f32_32x32x16_bf16(__builtin_bit_cast(bf16x8, av), pf, o[db], 0, 0, 0); }
            }
        const float inv = 1.0f / ls;
        bf16* op = AO + (tok0 + q0 + r32) * QW + hq * 64 + 4 * hi;
#pragma unroll
        for (int db = 0; db < 2; ++db)
#pragma unroll
            for (int g4 = 0; g4 < 4; ++g4) { v2u w; w.x = cvt_pk_bf16(o[db][4 * g4] * inv, o[db][4 * g4 + 1] * inv); w.y = cvt_pk_bf16(o[db][4 * g4 + 2] * inv, o[db][4 * g4 + 3] * inv);
                *(GAS v2u*)(op + db * 32 + 8 * g4) = w; }
        __syncthreads();
    }
}

__device__ __forceinline__ void ssm_precompute(const Args& a, LAS unsigned char* lds, int g, int wave, bf16* BTS, bf16* BTST, float* ABARL) {
    const int lane = lane_id_v(), tid = wave * 64 + lane;
    LAS f32x2* PW = (LAS f32x2*)lds;
    LAS f32x2* BB = (LAS f32x2*)(lds + 16896);
    LAS f32x2* CC = (LAS f32x2*)(lds + 16896 + 8192);
    LAS float* KT = (LAS float*)(lds + 16896 + 16384);
    const float dt = expf(a.in[8][g]);
    for (int i = tid; i < 33 * 64; i += 512) { const int d = i >> 6, p = i & 63; const float lr = a.in[6][g * 64 + p], li = a.in[7][g * 64 + p];
        const float mag = expf((float)d * (lr * dt)); float s, c; sincosf((float)d * (li * dt), &s, &c); PW[i] = (f32x2){mag * c, mag * s}; }
    for (int i = tid; i < 64 * 16; i += 512) { const int p = i >> 4; const float lr = a.in[6][g * 64 + p], li = a.in[7][g * 64 + p], th = li * dt;
        float s, c; sincosf(th, &s, &c); const float em1 = expm1f(lr * dt), sh = sinf(0.5f * th);
        const float xr = em1 * c - 2.0f * sh * sh, xi = (em1 + 1.0f) * s, den = lr * lr + li * li;
        const float fr = (xr * lr + xi * li) / den, fi = (xi * lr - xr * li) / den;
        const float br = a.in[9][(size_t)(g * 64) * 16 + i], bi = a.in[10][(size_t)(g * 64) * 16 + i];
        BB[i] = (f32x2){fr * br - fi * bi, fr * bi + fi * br}; }
    for (int i = tid; i < 16 * 64; i += 512) CC[i] = (f32x2){a.in[11][(size_t)g * 1024 + i], a.in[12][(size_t)g * 1024 + i]};
    __syncthreads();
    for (int i = tid; i < 32 * 256; i += 512) { const int d = i >> 8, ho = (i >> 4) & 15, hh = i & 15; float acc = 0.f;
        for (int p = 0; p < 64; ++p) { const f32x2 c = CC[ho * 64 + p], w = PW[d * 64 + p], bb = BB[p * 16 + hh];
            const float tr = c.x * w.x - c.y * w.y, ti = c.x * w.y + c.y * w.x; acc += tr * bb.x - ti * bb.y; }
        KT[i] = acc; }
    __syncthreads();
    for (int q = tid; q < 512 * (SSM_K / 8); q += 512) { const int n = q / (SSM_K / 8), k0 = (q % (SSM_K / 8)) * 8, i = n >> 4, ho = n & 15; float v[8];
        if (k0 < 512) { const int d = i - (k0 >> 4), h0 = k0 & 15;
#pragma unroll
            for (int e = 0; e < 8; ++e) v[e] = d >= 0 ? KT[((d < 0 ? 0 : d) * 16 + ho) * 16 + h0 + e] : 0.f; }
        else { const bool im = k0 >= 576; const int p0 = k0 - (im ? 576 : 512);
#pragma unroll
            for (int e = 0; e < 8; ++e) { const f32x2 c = CC[ho * 64 + p0 + e], w = PW[(i + 1) * 64 + p0 + e]; v[e] = im ? -(c.x * w.y + c.y * w.x) : (c.x * w.x - c.y * w.y); } }
        v4u o; o.x = cvt_pk_bf16(v[0], v[1]); o.y = cvt_pk_bf16(v[2], v[3]); o.z = cvt_pk_bf16(v[4], v[5]); o.w = cvt_pk_bf16(v[6], v[7]);
        *(GAS v4u*)(BTS + ((size_t)(g * 512 + n) * SSM_K + k0)) = o; }
    for (int q = tid; q < 256 * 64; q += 512) { const int n = q >> 6, k0 = (q & 63) * 8, j = k0 >> 4, h0 = k0 & 15, p = n & 63; float v[8];
        const f32x2 w = PW[(31 - j) * 64 + p];
#pragma unroll
        for (int e = 0; e < 8; ++e) { const f32x2 bb = BB[p * 16 + h0 + e]; const float re = w.x * bb.x - w.y * bb.y, im = w.x * bb.y + w.y * bb.x; v[e] = n < 64 ? re : (n < 128 ? im : 0.f); }
        v4u o; o.x = cvt_pk_bf16(v[0], v[1]); o.y = cvt_pk_bf16(v[2], v[3]); o.z = cvt_pk_bf16(v[4], v[5]); o.w = cvt_pk_bf16(v[6], v[7]);
        *(GAS v4u*)(BTST + ((size_t)(g * 256 + n) * 512 + k0)) = o; }
    if (tid < 64) { const f32x2 w = PW[32 * 64 + tid]; ABARL[(g * 64 + tid) * 2] = w.x; ABARL[(g * 64 + tid) * 2 + 1] = w.y; }
    __syncthreads();
}

struct SsmOrder {
    int G, c, npn; const char* A; const char* B; size_t b_g, b_tile;
    __device__ __forceinline__ bool next(int i, pg8::Unit& u) const {
        const int L = i * G + c; if (L >= SSM_G * 4 * npn) return false;
        const int g = L / (4 * npn), r = L % (4 * npn), rt = r / npn, pn = r % npn;
        u.A = A + (size_t)(g * 4 + rt) * 256 * (SSM_K * 2); u.B = B + (size_t)g * b_g + (size_t)pn * b_tile; u.pm = g * 4 + rt; u.pn = pn; u.aux = g; u.aux2 = 0; return true;
    }
};
struct EpiState {
    float* S;
    __device__ __forceinline__ void operator()(const f32x4 (&acc)[2][2][4][2], const pg8::Unit& u, int wr, int wc, int fr, int fq) const {
        const int row0 = u.pm * 256 + wr * 64 + fr, col0 = wc * 32 + fq * 4;
#pragma unroll
        for (int ai = 0; ai < 2; ++ai)
#pragma unroll
            for (int m = 0; m < 4; ++m)
#pragma unroll
                for (int n = 0; n < 2; ++n) *(f32x4*)(S + (size_t)(row0 + ai * 128 + m * 16) * 128 + col0 + n * 16) = acc[ai][0][m][n];
    }
};
__device__ __forceinline__ void phase_ssmb(int wave, const float* S, const float* ABARL, bf16* AS) {
    const int lane = lane_id_v(), idx = (blockIdx.x * NWAVES + wave) * 64 + lane;
    if (idx >= BATCH * SSM_G * SSM_P) return;
    const int p = idx & 63, g = (idx >> 6) & 31, b = idx >> 11;
    const float ar = ABARL[(g * 64 + p) * 2], ai = ABARL[(g * 64 + p) * 2 + 1];
    float hr = 0.f, hi = 0.f;
#pragma unroll 8
    for (int c = 0; c < SSM_NCH; ++c) { const size_t row = (size_t)g * SSM_ROWS + b * SSM_NCH + c;
        AS[row * SSM_K + 512 + p] = (bf16)(cvt_pk_bf16(hr, 0.f) & 0xffffu); AS[row * SSM_K + 576 + p] = (bf16)(cvt_pk_bf16(hi, 0.f) & 0xffffu);
        const float sr = S[row * 128 + p], si = S[row * 128 + 64 + p];
        const float nr = ar * hr - ai * hi + sr, ni = ar * hi + ai * hr + si; hr = nr; hi = ni; }
}
struct EpiSsmOut {
    const bf16* AS; const float* dsk; bf16* Z;
    __device__ __forceinline__ void operator()(const f32x4 (&acc)[2][2][4][2], const pg8::Unit& u, int wr, int wc, int fr, int fq) const {
        const int g = u.aux, rbase = (u.pm & 3) * 256 + wr * 64 + fr;
        const f32x4 dk = *(const f32x4*)(dsk + 16 * g + 4 * fq);
#pragma unroll
        for (int ai = 0; ai < 2; ++ai)
#pragma unroll
            for (int m = 0; m < 4; ++m) { const int rg = rbase + ai * 128 + m * 16, b = rg >> 6, ch = rg & 63;
                const bf16* arow = AS + ((size_t)g * SSM_ROWS + rg) * SSM_K + 4 * fq;
#pragma unroll
                for (int bj = 0; bj < 2; ++bj)
#pragma unroll
                    for (int n = 0; n < 2; ++n) { const int i = 16 * u.pn + 8 * bj + 2 * wc + n;
                        const v2u uw = *(const GAS v2u*)(arow + i * 16);
                        const f32x4 uu = {bf_lo(uw.x), bf_hi(uw.x), bf_lo(uw.y), bf_hi(uw.y)};
                        const f32x4 y = acc[ai][bj][m][n] + dk * uu;
                        v2u w; w.x = cvt_pk_bf16(gelu_tanh_f(y[0]), gelu_tanh_f(y[1])); w.y = cvt_pk_bf16(gelu_tanh_f(y[2]), gelu_tanh_f(y[3]));
                        *(GAS v2u*)(Z + ((size_t)b * SEQ + ch * 32 + i) * SSMW + 16 * g + 4 * fq) = w; } }
    }
};
struct EpiGlu {
    const bf16* GS; bf16* SG;
    __device__ __forceinline__ void operator()(const f32x4 (&acc)[2][2][4][2], const pg8::Unit& u, int wr, int wc, int fr, int fq) const {
        const int row0 = u.pm * 256 + wr * 64 + fr, pb = 128 * u.pn + 32 * wc + 16 * (fq & 1) + 4 * (fq >> 1);
#pragma unroll
        for (int ai = 0; ai < 2; ++ai)
#pragma unroll
            for (int m = 0; m < 4; ++m) { const size_t ro = (size_t)(row0 + ai * 128 + m * 16) * D + pb;
#pragma unroll
                for (int bj = 0; bj < 2; ++bj) { const v2u gw = *(const GAS v2u*)(GS + ro + 8 * bj);
                    const f32x4 gs = {bf_lo(gw.x), bf_hi(gw.x), bf_lo(gw.y), bf_hi(gw.y)}; const f32x4 av = acc[ai][bj][m][0], bv = acc[ai][bj][m][1];
                    v2u w; w.x = cvt_pk_bf16(gs[0] * av[0] * fast_sigmoid(bv[0]), gs[1] * av[1] * fast_sigmoid(bv[1]));
                    w.y = cvt_pk_bf16(gs[2] * av[2] * fast_sigmoid(bv[2]), gs[3] * av[3] * fast_sigmoid(bv[3]));
                    *(GAS v2u*)(SG + ro + 8 * bj) = w; } }
    }
};
struct EpiMixB {
    const bf16* GA; const bf16* SG; bf16* MIX;
    __device__ __forceinline__ void operator()(const f32x4 (&acc)[2][2][4][2], const pg8::Unit& u, int wr, int wc, int fr, int fq) const {
        const int row0 = u.pm * 256 + wr * 64 + fr, col0 = u.pn * 256 + wc * 32 + fq * 8;
#pragma unroll
        for (int ai = 0; ai < 2; ++ai)
#pragma unroll
            for (int m = 0; m < 4; ++m) { const size_t ro = (size_t)(row0 + ai * 128 + m * 16) * D + col0;
#pragma unroll
                for (int bj = 0; bj < 2; ++bj) { const v4u g = *(const GAS v4u*)(GA + ro + bj * 128), s = *(const GAS v4u*)(SG + ro + bj * 128);
                    const f32x4 v0 = acc[ai][bj][m][0], v1 = acc[ai][bj][m][1];
                    v4u w; w.x = cvt_pk_bf16(bf_lo(g.x) * v0[0] + bf_lo(s.x), bf_hi(g.x) * v0[1] + bf_hi(s.x)); w.y = cvt_pk_bf16(bf_lo(g.y) * v0[2] + bf_lo(s.y), bf_hi(g.y) * v0[3] + bf_hi(s.y));
                    w.z = cvt_pk_bf16(bf_lo(g.z) * v1[0] + bf_lo(s.z), bf_hi(g.z) * v1[1] + bf_hi(s.z)); w.w = cvt_pk_bf16(bf_lo(g.w) * v1[2] + bf_lo(s.w), bf_hi(g.w) * v1[3] + bf_hi(s.w));
                    *(GAS v4u*)(MIX + ro + bj * 128) = w; } }
    }
};

__device__ __forceinline__ void phase_prologue(const Args& a, LAS unsigned char* lds, int wave) {
    unsigned char* ws = a.ws; const int lane = lane_id_v();
    LAS float* scr = (LAS float*)(lds + wave * 16384);
    const int gw = blockIdx.x * NWAVES + wave, NGW = gridDim.x * NWAVES;
    constexpr int I_SQ = (D / 64) * (D / 32);
    constexpr int I_GU = (D / 64) * (2 * DE / 32), I_D = (DE / 64) * (D / 32);
    constexpr int I_IN = (D / 64) * (INW / 32), I_GL = (SSMW / 64) * (D / 32);
    constexpr int N_SMALL = 6 * I_SQ + I_IN + 2 * I_GL;
    if (blockIdx.x < SSM_G) ssm_precompute(a, lds, (int)blockIdx.x, wave, (bf16*)(ws + WS_BTS), (bf16*)(ws + WS_BTST), (float*)(ws + WS_ABARL));
    for (int it = gw; it < N_SMALL + NE * (I_GU + I_D); it += NGW) {
        int r = it;
        if (r < I_IN) { transpose_item(a.in[3], D, INW, (bf16*)(ws + WS_WIN), scr, r, lane, PermWin{}); continue; } r -= I_IN;
        if (r < I_SQ) { transpose_item<PermId, true>(a.in[5], D, D, (bf16*)(ws + WS_WAO), scr, r, lane, PermId{}); continue; } r -= I_SQ;
        if (r < I_GL) { transpose_item(a.in[14], SSMW, D, (bf16*)(ws + WS_WGLU), scr, r, lane, PermGlu<0>{}); continue; } r -= I_GL;
        if (r < I_GL) { transpose_item(a.in[15], SSMW, D, (bf16*)(ws + WS_WGLU), scr, r, lane, PermGlu<1>{}); continue; } r -= I_GL;
        if (r < I_SQ) { transpose_item<PermId, true>(a.in[16], D, D, (bf16*)(ws + WS_WOUT), scr, r, lane, PermId{}); continue; } r -= I_SQ;
        if (r < I_SQ) { transpose_item(a.in[19], D, D, (bf16*)(ws + WS_WQ), scr, r, lane, PermId{}); continue; } r -= I_SQ;
        if (r < I_SQ) { transpose_item(a.in[20], D, D, (bf16*)(ws + WS_WK), scr, r, lane, PermId{}); continue; } r -= I_SQ;
        if (r < I_SQ) { transpose_item(a.in[21], D, D, (bf16*)(ws + WS_WV), scr, r, lane, PermId{}); continue; } r -= I_SQ;
        if (r < I_SQ) { transpose_item<PermId, true>(a.in[22], D, D, (bf16*)(ws + WS_WOC), scr, r, lane, PermId{}); continue; } r -= I_SQ;
        if (r < NE * I_GU) { const int e = r / I_GU, q = r % I_GU;
            transpose_item(a.in[27] + (size_t)e * D * 2 * DE, D, 2 * DE, (bf16*)(ws + WS_WGU) + (size_t)e * 2 * DE * D, scr, q, lane, PermGU{}); continue; } r -= NE * I_GU;
        { const int e = r / I_D, q = r % I_D;
            transpose_item(a.in[29] + (size_t)e * DE * D, DE, D, (bf16*)(ws + WS_WD) + (size_t)e * D * DE, scr, q, lane, PermId{}); }
    }
    cvt_rows(a.in[1], (bf16*)(ws + WS_MEMB), (size_t)BATCH * NMEM * D, lane, wave);
    cvt_rows(a.in[0], (bf16*)(ws + WS_XB), (size_t)T * D, lane, wave);
    { const int* pos = (const int*)a.in[2]; float* cs = (float*)(ws + WS_CS);
      for (int i = gw * 64 + lane; i < T * 32; i += NGW * 64) { const float inv = powf(10000.0f, -(float)(i & 31) / 32.0f); float s, c; sincosf((float)pos[i >> 5] * inv, &s, &c);
          *(f32x2*)(cs + 2 * (size_t)i) = (f32x2){c, s}; } }
    for (int i = gw * 64 + lane; i < D * NE; i += NGW * 64) {
        const int j = i & 7, col = (i >> 3) & 31, h = (i >> 8) & 1, s = i >> 9;
        const float w = a.in[25][(size_t)(16 * s + 8 * h + j) * NE + col];
        const unsigned hb = cvt_pk_bf16(w, 0.f) & 0xffffu; const unsigned lb = cvt_pk_bf16(w - __uint_as_float(hb << 16), 0.f) & 0xffffu;
        ((bf16*)(ws + WS_WRF))[i] = (bf16)hb; ((bf16*)(ws + WS_WRF + 65536))[i] = (bf16)lb;
    }
}

enum { PH_PRO = 0, PH_INPROJ = 1, PH_KV = 2, PH_ATTN = 3, PH_SSMA = 4, PH_SSMB = 5, PH_SSMC = 6, PH_GLU = 7, PH_AOUT = 8, PH_WOUT = 9, PH_LN1 = 10,
       PH_QC = 11, PH_S = 12, PH_PV = 13, PH_WOC = 14, PH_LN2 = 15, PH_ROUTER = 16, PH_SLOTS = 17, PH_MOE1 = 18, PH_MOE2 = 19, PH_COMBINE = 20, PH_N = 21 };
__global__ void __launch_bounds__(NWAVES * 64, 2) mk_fwd(Args a) {
    extern __shared__ __attribute__((aligned(16))) unsigned char lds_raw[];
    LAS unsigned char* lds = (LAS unsigned char*)lds_raw;
    volatile LAS unsigned* MISC = (volatile LAS unsigned*)(lds + MISC_OFF);
    const int wave = __builtin_amdgcn_readfirstlane(threadIdx.x >> 6);
    for (int u = threadIdx.x; u < (LDS_BYTES - MISC_OFF) / 4; u += NWAVES * 64) ((LAS unsigned*)(lds + MISC_OFF))[u] = 0u;
    __syncthreads();
    unsigned char* ws = a.ws;
    XcdBarrier bar = xcd_barrier_post((unsigned*)(ws + WS_CTL) + CW_BAR, MISC + 8);
    const unsigned long long mask = a.mask;
#define RUN(k) ((mask >> (k)) & 1ull)
#define SEAM(k) do { if (mask >> ((k) + 1)) xcd_barrier(bar, wave); } while (0)

    if (RUN(PH_PRO)) { phase_prologue(a, lds, wave); SEAM(PH_PRO); }

    if (RUN(PH_INPROJ)) {
        GridOrder S = grid_order(T, INW, 0, ws + WS_XB, D * 2, ws + WS_WIN, D * 2);
        EpiInproj E{(bf16*)(ws + WS_QR), (bf16*)(ws + WS_KR), (bf16*)(ws + WS_VR), (bf16*)(ws + WS_AS), (bf16*)(ws + WS_GA), (bf16*)(ws + WS_GS), (const float*)(ws + WS_CS)};
        pg8::gemm_phase<EpiInproj, GridOrder>(lds, pg8::Gemm{D * 2, D * 2, D}, S, E, wave);
    }
    if (RUN(PH_KV)) {
        { GridOrder S = grid_order(BATCH * NMEM, D, 128, ws + WS_MEMB, D * 2, ws + WS_WK, D * 2);
          EpiBf16N8 E{(bf16*)(ws + WS_KC), D, 1.0f}; pg8::gemm_phase<EpiBf16N8, GridOrder>(lds, pg8::Gemm{D * 2, D * 2, D}, S, E, wave); }
        { GridOrder S = grid_order(D, BATCH * NMEM, 64, ws + WS_WV, D * 2, ws + WS_MEMB, D * 2);
          EpiBf16N8 E{(bf16*)(ws + WS_VCT), BATCH * NMEM, 1.0f}; pg8::gemm_phase<EpiBf16N8, GridOrder>(lds, pg8::Gemm{D * 2, D * 2, D}, S, E, wave); }
    }
    if (RUN(PH_INPROJ) || RUN(PH_KV)) SEAM(PH_KV);
    if (RUN(PH_ATTN)) phase_attn(a, lds, wave, (const bf16*)(ws + WS_QR), (const bf16*)(ws + WS_KR), (const bf16*)(ws + WS_VR), (bf16*)(ws + WS_AO));
    if (RUN(PH_SSMA)) {
        SsmOrder S{(int)gridDim.x, (int)((blockIdx.x + 128u) % gridDim.x), 1, (const char*)(ws + WS_AS), (const char*)(ws + WS_BTST), (size_t)256 * 512 * 2, 0};
        EpiState E{(float*)(ws + WS_SST)};
        pg8::gemm_phase<EpiState, SsmOrder>(lds, pg8::Gemm{SSM_K * 2, 512 * 2, 512}, S, E, wave);
    }
    if (RUN(PH_ATTN) || RUN(PH_SSMA)) SEAM(PH_SSMA);
    if (RUN(PH_SSMB)) { phase_ssmb(wave, (const float*)(ws + WS_SST), (const float*)(ws + WS_ABARL), (bf16*)(ws + WS_AS)); SEAM(PH_SSMB); }
    if (RUN(PH_SSMC)) {
        SsmOrder S{(int)gridDim.x, (int)blockIdx.x, 2, (const char*)(ws + WS_AS), (const char*)(ws + WS_BTS), (size_t)512 * SSM_K * 2, (size_t)256 * SSM_K * 2};
        EpiSsmOut E{(const bf16*)(ws + WS_AS), a.in[13], (bf16*)(ws + WS_Z)};
        pg8::gemm_phase<EpiSsmOut, SsmOrder>(lds, pg8::Gemm{SSM_K * 2, SSM_K * 2, SSM_K}, S, E, wave);
        SEAM(PH_SSMC);
    }
    if (RUN(PH_GLU)) {
        GridOrder S = grid_order(T, 2 * D, 0, ws + WS_Z, SSMW * 2, ws + WS_WGLU, SSMW * 2);
        EpiGlu E{(const bf16*)(ws + WS_GS), (bf16*)(ws + WS_SG)};
        pg8::gemm_phase<EpiGlu, GridOrder>(lds, pg8::Gemm{SSMW * 2, SSMW * 2, SSMW}, S, E, wave);
        SEAM(PH_GLU);
    }
    if (RUN(PH_AOUT)) {
        GridOrder S = grid_order(T, D, 0, ws + WS_AO, D * 2, ws + WS_WAO, D * 2);
        EpiMixB E{(const bf16*)(ws + WS_GA), (const bf16*)(ws + WS_SG), (bf16*)(ws + WS_MIX)};
        pg8::gemm_phase<EpiMixB, GridOrder>(lds, pg8::Gemm{D * 2, D * 2, D}, S, E, wave);
        SEAM(PH_AOUT);
    }
    if (RUN(PH_WOUT)) {
        GridOrder S = grid_order(T, D, 0, ws + WS_MIX, D * 2, ws + WS_WOUT, D * 2);
        EpiResF32 E{(float*)(ws + WS_PRE1), a.in[0]}; pg8::gemm_phase<EpiResF32, GridOrder>(lds, pg8::Gemm{D * 2, D * 2, D}, S, E, wave);
        SEAM(PH_WOUT);
    }
    if (RUN(PH_LN1)) { phase_ln((const float*)(ws + WS_PRE1), a.in[17], a.in[18], (float*)(ws + WS_X1), (bf16*)(ws + WS_X1B), wave); SEAM(PH_LN1); }
    if (RUN(PH_QC)) {
        GridOrder S = grid_order(T, D, 0, ws + WS_X1B, D * 2, ws + WS_WQ, D * 2);
        EpiBf16N8 E{(bf16*)(ws + WS_QC), D, 0.0625f}; pg8::gemm_phase<EpiBf16N8, GridOrder>(lds, pg8::Gemm{D * 2, D * 2, D}, S, E, wave);
        SEAM(PH_QC);
    }
    if (RUN(PH_S)) {
        BhOrder S{(int)gridDim.x, (int)blockIdx.x, (const char*)(ws + WS_QC), (const char*)(ws + WS_KC), (size_t)SEQ * D * 2, (size_t)256 * D * 2, (size_t)CHD * 2, (size_t)NMEM * D * 2, (size_t)CHD * 2};
        EpiSoftmax E{(bf16*)(ws + WS_PM), D, (LAS f32x2*)(lds + MISC_OFF + 4096)};
        pg8::gemm_phase<EpiSoftmax, BhOrder>(lds, pg8::Gemm{D * 2, D * 2, CHD}, S, E, wave);
        SEAM(PH_S);
    }
    if (RUN(PH_PV)) {
        BhOrder S{(int)gridDim.x, (int)blockIdx.x, (const char*)(ws + WS_PM), (const char*)(ws + WS_VCT), (size_t)SEQ * D * 2, (size_t)256 * D * 2, (size_t)NMEM * 2, (size_t)NMEM * 2, (size_t)CHD * BATCH * NMEM * 2};
        EpiBf16N8 E{(bf16*)(ws + WS_OC), D, 1.0f};
        pg8::gemm_phase<EpiBf16N8, BhOrder>(lds, pg8::Gemm{D * 2, BATCH * NMEM * 2, NMEM}, S, E, wave);
        SEAM(PH_PV);
    }
    if (RUN(PH_WOC)) {
        GridOrder S = grid_order(T, D, 0, ws + WS_OC, D * 2, ws + WS_WOC, D * 2);
        EpiResF32 E{(float*)(ws + WS_PRE2), (const float*)(ws + WS_X1)}; pg8::gemm_phase<EpiResF32, GridOrder>(lds, pg8::Gemm{D * 2, D * 2, D}, S, E, wave);
        SEAM(PH_WOC);
    }
    if (RUN(PH_LN2)) { phase_ln((const float*)(ws + WS_PRE2), a.in[23], a.in[24], (float*)(ws + WS_X2), nullptr, wave); SEAM(PH_LN2); }

    if (RUN(PH_ROUTER)) { phase_router(a, lds, wave); SEAM(PH_ROUTER); }
    if (RUN(PH_SLOTS)) { phase_slots(a, wave); SEAM(PH_SLOTS); }
    if (RUN(PH_MOE1)) {
        int stl; const int ntot = expert_tiles(a, lane_id_v(), stl);
        MoeOrder S{stl, ntot, 3, (int)gridDim.x, (int)blockIdx.x, (const char*)(ws + WS_RA), (const char*)(ws + WS_WGU), (size_t)256 * D * 2, (size_t)256 * D * 2, (size_t)2 * DE * D * 2};
        EpiSwigluB E{(bf16*)(ws + WS_RB), a.in[28]};
        pg8::gemm_phase<EpiSwigluB, MoeOrder>(lds, pg8::Gemm{D * 2, D * 2, D}, S, E, wave);
        SEAM(PH_MOE1);
    }
    if (RUN(PH_MOE2)) {
        int stl; const int ntot = expert_tiles(a, lane_id_v(), stl);
        MoeOrder S{stl, ntot, 2, (int)gridDim.x, (int)blockIdx.x, (const char*)(ws + WS_RB), (const char*)(ws + WS_WD), (size_t)256 * DE * 2, (size_t)256 * DE * 2, (size_t)D * DE * 2};
        EpiDownB E{(bf16*)(ws + WS_RA), a.in[30], (const float*)(ws + WS_SLOTGATE)};
        pg8::gemm_phase<EpiDownB, MoeOrder>(lds, pg8::Gemm{DE * 2, DE * 2, DE}, S, E, wave);
        SEAM(PH_MOE2);
    }
    if (RUN(PH_COMBINE)) { phase_combine(a, wave); }
#undef RUN
#undef SEAM
}

extern "C" void kernel_launch(void* const* d_in, const int* in_sizes, int n_in, void* d_out, int out_size, void* d_ws, size_t ws_size, hipStream_t stream) {
    static int ready = 0;
    if (!ready) {
        if (n_in != 33 || ws_size < WS_END) { fprintf(stderr, "kernel_launch: unexpected n_in %d / ws_size %zu\n", n_in, ws_size); ready = -1; return; }
        if (hipFuncSetAttribute((const void*)mk_fwd, hipFuncAttributeMaxDynamicSharedMemorySize, LDS_BYTES) != hipSuccess) { fprintf(stderr, "hipFuncSetAttribute failed\n"); ready = -1; return; }
        ready = 1;
    }
    if (ready < 0) return;
    char* ws = (char*)d_ws;
    (void)hipMemsetAsync(ws + WS_CTL, 0, CTL_ZERO_BYTES, stream);
    Args a{};
    for (int i = 0; i < 33; ++i) a.in[i] = (const float*)d_in[i];
    a.out = (float*)d_out; a.ws = (unsigned char*)d_ws;
    a.mask = (1ull << PH_N) - 1ull;
    hipLaunchKernelGGL(mk_fwd, dim3(256), dim3(NWAVES * 64), LDS_BYTES, stream, a);
}
```

```cpp
#include <hip/hip_runtime.h>
#include <cstdio>
#include <cstdint>
#include <cmath>

constexpr int BATCH = 16, SEQ = 2048, D = 1024, T = BATCH * SEQ;
constexpr int NQH = 16, NKVH = 2, HD = 64, WINDOW = 128;
constexpr int QW = 1024, KVW = 128, SSMW = 512, SSM_G = 32, SSM_H = 16, SSM_P = 64;
constexpr int INW = QW + 2 * KVW + SSMW + 2 * D;
constexpr int O_K = QW, O_V = O_K + KVW, O_S = O_V + KVW, O_GA = O_S + SSMW, O_GS = O_GA + D;
constexpr int NMEM = 256, NCH = 4, CHD = 256;
constexpr int NE = 32, TOPK = 4, DE = 1024;
constexpr float LN_EPS = 1e-5f;
constexpr float ALPHA = 1.189207115002721f;
constexpr int NASSIGN = T * TOPK;

namespace nv {
template <class Epi>
__global__ __launch_bounds__(256) void sgemm(const float* __restrict__ A, const int* __restrict__ ridx,
                                             const float* __restrict__ B, const int* __restrict__ tile_e, size_t bstride,
                                             int lda, int ldb, int M, int N, int K, int pad_, Epi epi) {
    __shared__ float As[16][68];
    __shared__ float Bs[16][68];
    const int tid = threadIdx.x, tx = tid & 15, ty = tid >> 4;
    const int m0 = blockIdx.y * 64, n0 = blockIdx.x * 64;
    int e = 0;
    if (tile_e) { e = tile_e[blockIdx.y]; if (e < 0) return; }
    const float* Bp = B + (size_t)e * bstride;
    float acc[4][4];
#pragma unroll
    for (int i = 0; i < 4; ++i)
#pragma unroll
        for (int j = 0; j < 4; ++j) acc[i][j] = 0.f;
    const int arow = tid >> 2, akq = (tid & 3) * 4;
    long asrc = -1;
    if (m0 + arow < M) { int r = m0 + arow; if (ridx) r = ridx[r]; asrc = (long)r * lda; }
    const int brow = tid >> 4, bcol = (tid & 15) * 4;
    for (int k0 = 0; k0 < K; k0 += 16) {
        float4 a = make_float4(0.f, 0.f, 0.f, 0.f);
        if (asrc >= 0) a = *(const float4*)(A + asrc + k0 + akq);
        As[akq + 0][arow] = a.x; As[akq + 1][arow] = a.y; As[akq + 2][arow] = a.z; As[akq + 3][arow] = a.w;
        float4 b = make_float4(0.f, 0.f, 0.f, 0.f);
        if (n0 + bcol < N) b = *(const float4*)(Bp + (size_t)(k0 + brow) * ldb + n0 + bcol);
        Bs[brow][bcol + 0] = b.x; Bs[brow][bcol + 1] = b.y; Bs[brow][bcol + 2] = b.z; Bs[brow][bcol + 3] = b.w;
        __syncthreads();
#pragma unroll
        for (int kk = 0; kk < 16; ++kk) {
            float av[4], bv[4];
#pragma unroll
            for (int i = 0; i < 4; ++i) av[i] = As[kk][ty * 4 + i];
#pragma unroll
            for (int j = 0; j < 4; ++j) bv[j] = Bs[kk][tx * 4 + j];
#pragma unroll
            for (int i = 0; i < 4; ++i)
#pragma unroll
                for (int j = 0; j < 4; ++j) acc[i][j] = fmaf(av[i], bv[j], acc[i][j]);
        }
        __syncthreads();
    }
#pragma unroll
    for (int i = 0; i < 4; ++i) {
        const int r = m0 + ty * 4 + i;
        if (r < M && n0 + tx * 4 < N) epi(r, n0 + tx * 4, acc[i], e);
    }
}

struct EpiStore { float* C; int ldc; int pad_;
    __device__ void operator()(int r, int c, const float (&v)[4], int) const { *(float4*)(C + (size_t)r * ldc + c) = make_float4(v[0], v[1], v[2], v[3]); } };
struct EpiStoreScale { float* C; int ldc; float s;
    __device__ void operator()(int r, int c, const float (&v)[4], int) const { *(float4*)(C + (size_t)r * ldc + c) = make_float4(v[0] * s, v[1] * s, v[2] * s, v[3] * s); } };
__device__ __forceinline__ float sigmoidf_(float x) { return 1.f / (1.f + expf(-x)); }
struct EpiMix { float* attn_out; const float* glu_a; const float* proj;
    __device__ void operator()(int r, int c, const float (&v)[4], int) const {
#pragma unroll
        for (int j = 0; j < 4; ++j) { const size_t o = (size_t)r * D + c + j;
            const float ga = sigmoidf_(proj[(size_t)r * INW + O_GA + c + j]), gs = sigmoidf_(proj[(size_t)r * INW + O_GS + c + j]);
            attn_out[o] = ga * attn_out[o] + gs * (glu_a[o] * sigmoidf_(v[j])); } } };
struct EpiResid { float* C; const float* res;
    __device__ void operator()(int r, int c, const float (&v)[4], int) const {
#pragma unroll
        for (int j = 0; j < 4; ++j) { const size_t o = (size_t)r * D + c + j; C[o] = ALPHA * res[o] + v[j]; } } };
struct EpiBias { float* C; const float* bias; int ldc; int N;
    __device__ void operator()(int r, int c, const float (&v)[4], int) const {
#pragma unroll
        for (int j = 0; j < 4; ++j) if (c + j < N) C[(size_t)r * ldc + c + j] = v[j] + bias[c + j]; } };
struct EpiSwiglu { float* H; const float* bgu;
    __device__ void operator()(int r, int c, const float (&v)[4], int e) const {
#pragma unroll
        for (int j = 0; j < 2; ++j) {
            float g = v[2 * j] + bgu[(size_t)e * 2 * DE + c + 2 * j], l = v[2 * j + 1] + bgu[(size_t)e * 2 * DE + c + 2 * j + 1];
            g = fminf(g, 7.0f); l = fminf(fmaxf(l, -7.0f), 7.0f);
            H[(size_t)r * DE + (c >> 1) + j] = g * sigmoidf_(1.702f * g) * (l + 1.0f); } } };
struct EpiDown { float* pre3; const float* bd; const int* slot_tok; const float* slot_gate;
    __device__ void operator()(int r, int c, const float (&v)[4], int e) const {
        const float g = slot_gate[r]; if (g == 0.f) return; const int tok = slot_tok[r];
#pragma unroll
        for (int j = 0; j < 4; ++j) atomicAdd(pre3 + (size_t)tok * D + c + j, (v[j] + bd[(size_t)e * D + c + j]) * g); } };

__global__ void rope_k(float* proj, const int* pos) {
    const size_t gid = (size_t)blockIdx.x * blockDim.x + threadIdx.x;
    if (gid >= (size_t)T * 18 * 32) return;
    const int i = gid & 31; const int hh = (gid >> 5) % 18; const size_t tok = gid / (18 * 32);
    const float inv = powf(10000.0f, -(float)i / 32.0f);
    const float ang = (float)pos[tok] * inv; const float c = cosf(ang), s = sinf(ang);
    float* p = proj + tok * INW + (hh < 16 ? hh * 64 : O_K + (hh - 16) * 64);
    const float t1 = p[i], t2 = p[i + 32];
    p[i] = t1 * c - t2 * s; p[i + 32] = t2 * c + t1 * s;
}
__global__ __launch_bounds__(64) void swa_k(const float* __restrict__ proj, const float* __restrict__ sinks, float* __restrict__ out) {
    const int gid = blockIdx.x * blockDim.x + threadIdx.x;
    if (gid >= T * NQH) return;
    const int hq = gid % NQH, tok = gid / NQH, t = tok % SEQ, b = tok / SEQ, kvh = hq / 8;
    float q[64], acc[64];
    const float* qp = proj + (size_t)tok * INW + hq * 64;
#pragma unroll
    for (int d = 0; d < 64; ++d) { q[d] = qp[d] * 0.125f; acc[d] = 0.f; }
    float m = sinks[hq], l = 1.0f;
    const int k0 = t - (WINDOW - 1) < 0 ? 0 : t - (WINDOW - 1);
    for (int kp = k0; kp <= t; ++kp) {
        const float* kr = proj + (size_t)(b * SEQ + kp) * INW + O_K + kvh * 64;
        const float* vr = proj + (size_t)(b * SEQ + kp) * INW + O_V + kvh * 64;
        float s = 0.f;
#pragma unroll
        for (int d = 0; d < 64; ++d) s = fmaf(q[d], kr[d], s);
        if (s > m) { const float sc = expf(m - s); l *= sc;
#pragma unroll
            for (int d = 0; d < 64; ++d) acc[d] *= sc;
            m = s; }
        const float p = expf(s - m); l += p;
#pragma unroll
        for (int d = 0; d < 64; ++d) acc[d] = fmaf(p, vr[d], acc[d]);
    }
    const float il = 1.0f / l;
    float* op = out + (size_t)tok * QW + hq * 64;
#pragma unroll
    for (int d = 0; d < 64; ++d) op[d] = acc[d] * il;
}
__global__ void ssm_pre_k(const float* lam_re, const float* lam_im, const float* log_dt, const float* b_re, const float* b_im,
                          float* abar, float* bbar) {
    const int gp = blockIdx.x * blockDim.x + threadIdx.x; if (gp >= SSM_G * SSM_P) return;
    const int g = gp / SSM_P;
    const float lr = lam_re[gp], li = lam_im[gp], dt = expf(log_dt[g]);
    const float mag = expf(lr * dt), ar = mag * cosf(li * dt), ai = mag * sinf(li * dt);
    const float den = lr * lr + li * li;
    const float fr = ((ar - 1.0f) * lr + ai * li) / den, fi = (ai * lr - (ar - 1.0f) * li) / den;
    abar[gp * 2] = ar; abar[gp * 2 + 1] = ai;
    for (int h = 0; h < 16; ++h) { const float br = b_re[gp * 16 + h], bi = b_im[gp * 16 + h];
        bbar[(gp * 2) * 16 + h] = fr * br - fi * bi; bbar[(gp * 2 + 1) * 16 + h] = fr * bi + fi * br; }
}
__device__ __forceinline__ float gelu_tanh(float x) { return 0.5f * x * (1.0f + tanhf(0.7978845608028654f * (x + 0.044715f * x * x * x))); }
__global__ __launch_bounds__(64) void ssm_scan_k(const float* __restrict__ proj, const float* __restrict__ abar, const float* __restrict__ bbar,
                                                 const float* __restrict__ c_re, const float* __restrict__ c_im, const float* __restrict__ d_skip, float* __restrict__ z) {
    const int g = blockIdx.x % SSM_G, b = blockIdx.x / SSM_G, p = threadIdx.x, gp = g * SSM_P + p;
    const float ar = abar[gp * 2], ai = abar[gp * 2 + 1];
    float br[16], bi[16], cr[16], ci[16];
#pragma unroll
    for (int h = 0; h < 16; ++h) { br[h] = bbar[(gp * 2) * 16 + h]; bi[h] = bbar[(gp * 2 + 1) * 16 + h];
        cr[h] = c_re[(g * 16 + h) * SSM_P + p]; ci[h] = c_im[(g * 16 + h) * SSM_P + p]; }
    const float dsk = p < 16 ? d_skip[g * 16 + p] : 0.f;
    const int pu = p < 16 ? p : 0;
    float hr = 0.f, hi = 0.f;
    for (int t = 0; t < SEQ; ++t) {
        const float* up = proj + (size_t)(b * SEQ + t) * INW + O_S + g * 16;
        float u[16];
#pragma unroll
        for (int h = 0; h < 16; ++h) u[h] = up[h];
        float bur = 0.f, bui = 0.f;
#pragma unroll
        for (int h = 0; h < 16; ++h) { bur = fmaf(br[h], u[h], bur); bui = fmaf(bi[h], u[h], bui); }
        const float nr = ar * hr - ai * hi + bur, ni = ar * hi + ai * hr + bui; hr = nr; hi = ni;
        float mine = 0.f;
#pragma unroll
        for (int h = 0; h < 16; ++h) { float v = cr[h] * hr - ci[h] * hi;
#pragma unroll
            for (int o = 32; o >= 1; o >>= 1) v += __shfl_xor(v, o);
            if (p == h) mine = v; }
        const float uown = up[pu];
        if (p < 16) { const float y = mine + dsk * uown; z[(size_t)(b * SEQ + t) * SSMW + g * 16 + p] = gelu_tanh(y); }
    }
}
__global__ __launch_bounds__(256) void ln_k(const float* __restrict__ in, const float* __restrict__ g, const float* __restrict__ bta, float* __restrict__ out, int rows, int pad_) {
    const int row = blockIdx.x * 4 + (threadIdx.x >> 6), lane = threadIdx.x & 63; if (row >= rows) return;
    const float* r = in + (size_t)row * D; float v[16]; float s = 0.f;
#pragma unroll
    for (int j = 0; j < 16; ++j) { v[j] = r[lane + 64 * j]; s += v[j]; }
#pragma unroll
    for (int o = 32; o >= 1; o >>= 1) s += __shfl_xor(s, o);
    const float mean = s * (1.0f / D); float q = 0.f;
#pragma unroll
    for (int j = 0; j < 16; ++j) { v[j] -= mean; q += v[j] * v[j]; }
#pragma unroll
    for (int o = 32; o >= 1; o >>= 1) q += __shfl_xor(q, o);
    const float rstd = rsqrtf(q * (1.0f / D) + LN_EPS);
#pragma unroll
    for (int j = 0; j < 16; ++j) out[(size_t)row * D + lane + 64 * j] = v[j] * rstd * g[lane + 64 * j] + bta[lane + 64 * j];
}
__global__ __launch_bounds__(256) void xattn_k(const float* __restrict__ qc, const float* __restrict__ kc, const float* __restrict__ vc, float* __restrict__ oc) {
    const int w = blockIdx.x * 4 + (threadIdx.x >> 6), lane = threadIdx.x & 63; if (w >= T * NCH) return;
    const int h = w % NCH, tok = w / NCH, b = tok / SEQ;
    const float4 q = *(const float4*)(qc + (size_t)tok * D + h * CHD + lane * 4);
    float m = -INFINITY, l = 0.f; float4 acc = make_float4(0.f, 0.f, 0.f, 0.f);
    for (int mm = 0; mm < NMEM; ++mm) {
        const float4 k = *(const float4*)(kc + (size_t)(b * NMEM + mm) * D + h * CHD + lane * 4);
        float s = q.x * k.x + q.y * k.y + q.z * k.z + q.w * k.w;
#pragma unroll
        for (int o = 32; o >= 1; o >>= 1) s += __shfl_xor(s, o);
        if (s > m) { const float sc = expf(m - s); l *= sc; acc.x *= sc; acc.y *= sc; acc.z *= sc; acc.w *= sc; m = s; }
        const float p = expf(s - m); l += p;
        const float4 v = *(const float4*)(vc + (size_t)(b * NMEM + mm) * D + h * CHD + lane * 4);
        acc.x = fmaf(p, v.x, acc.x); acc.y = fmaf(p, v.y, acc.y); acc.z = fmaf(p, v.z, acc.z); acc.w = fmaf(p, v.w, acc.w);
    }
    const float il = 1.0f / l;
    *(float4*)(oc + (size_t)tok * D + h * CHD + lane * 4) = make_float4(acc.x * il, acc.y * il, acc.z * il, acc.w * il);
}
__global__ void topk_k(const float* __restrict__ logits, int* __restrict__ tidx, float* __restrict__ tgate, int* __restrict__ trank, int* __restrict__ cnt) {
    const int tok = blockIdx.x * blockDim.x + threadIdx.x; if (tok >= T) return;
    float lg[NE];
#pragma unroll
    for (int e = 0; e < NE; ++e) lg[e] = logits[(size_t)tok * NE + e];
    unsigned used = 0; float tv[4]; int ti[4];
#pragma unroll
    for (int k = 0; k < 4; ++k) { float best = -INFINITY; int bi = 0;
#pragma unroll
        for (int e = 0; e < NE; ++e) { const bool ok = !((used >> e) & 1u) && lg[e] > best; best = ok ? lg[e] : best; bi = ok ? e : bi; }
        used |= 1u << bi; tv[k] = best; ti[k] = bi; }
    const float mx = tv[0]; float ex[4], s = 0.f;
#pragma unroll
    for (int k = 0; k < 4; ++k) { ex[k] = expf(tv[k] - mx); s += ex[k]; }
#pragma unroll
    for (int k = 0; k < 4; ++k) { tidx[tok * 4 + k] = ti[k]; tgate[tok * 4 + k] = ex[k] / s; trank[tok * 4 + k] = atomicAdd(cnt + ti[k], 1); }
}
__global__ void offs_k(const int* __restrict__ cnt, int* __restrict__ off, int* __restrict__ tile_e, int ntiles, int pad_) {
    if (threadIdx.x != 0 || blockIdx.x != 0) return;
    int o = 0, tl = 0;
    for (int e = 0; e < NE; ++e) { off[e] = o; const int nt = (cnt[e] + 63) / 64; for (int i = 0; i < nt; ++i) tile_e[tl++] = e; o += nt * 64; }
    for (; tl < ntiles; ++tl) tile_e[tl] = -1;
}
__global__ void fill_k(const int* __restrict__ tidx, const float* __restrict__ tgate, const int* __restrict__ trank, const int* __restrict__ off,
                       int* __restrict__ slot_tok, float* __restrict__ slot_gate) {
    const int a = blockIdx.x * blockDim.x + threadIdx.x; if (a >= NASSIGN) return;
    const int slot = off[tidx[a]] + trank[a]; slot_tok[slot] = a >> 2; slot_gate[slot] = tgate[a];
}
__global__ void scale_k(const float* __restrict__ in, float* __restrict__ out, size_t n, float s, int pad_) {
    const size_t i = (size_t)blockIdx.x * blockDim.x + threadIdx.x; if (i < n) out[i] = in[i] * s;
}
}


#define GAS __attribute__((address_space(1)))
#define LAS __attribute__((address_space(3)))
typedef unsigned short bf16;
typedef unsigned v4u __attribute__((ext_vector_type(4)));
typedef unsigned v2u __attribute__((ext_vector_type(2)));
typedef float f32x4 __attribute__((ext_vector_type(4)));
typedef float f32x2 __attribute__((ext_vector_type(2)));
typedef float f32x16 __attribute__((ext_vector_type(16)));
typedef short bf16x8 __attribute__((ext_vector_type(8)));
typedef GAS unsigned gu32;
#define RLX_AGENT __ATOMIC_RELAXED, __HIP_MEMORY_SCOPE_AGENT
#define LDS_WAIT() asm volatile("s_waitcnt lgkmcnt(0)" ::: "memory")
#define VM_WAIT() asm volatile("s_waitcnt vmcnt(0)" ::: "memory")

typedef __bf16 bf16x2_t __attribute__((ext_vector_type(2)));
__device__ __forceinline__ unsigned cvt_pk_bf16(float lo, float hi) { const f32x2 v = {lo, hi}; const bf16x2_t b = __builtin_convertvector(v, bf16x2_t); return __builtin_bit_cast(unsigned, b); }
__device__ __forceinline__ float bf_lo(unsigned w) { return __uint_as_float(w << 16); }
__device__ __forceinline__ float bf_hi(unsigned w) { return __uint_as_float(w & 0xffff0000u); }
__device__ __forceinline__ float fast_sigmoid(float x) { return __builtin_amdgcn_rcpf(1.0f + __builtin_amdgcn_exp2f(-1.4426950408889634f * x)); }
__device__ __forceinline__ int lane_id_v() { int l; asm volatile("v_mbcnt_lo_u32_b32 %0, -1, 0\n\tv_mbcnt_hi_u32_b32 %0, -1, %0" : "=v"(l)); return l; }
__device__ __forceinline__ float wave_sum(float v) {
#pragma unroll
    for (int o = 1; o < 64; o <<= 1) v += __shfl_xor(v, o);
    return v;
}

typedef int v8i __attribute__((ext_vector_type(8)));
typedef int v4i __attribute__((ext_vector_type(4)));
__device__ __forceinline__ unsigned cvt4_fp8(float a, float b, float c, float d) { int w = __builtin_amdgcn_cvt_pk_fp8_f32(a, b, 0, false); w = __builtin_amdgcn_cvt_pk_fp8_f32(c, d, w, true); return (unsigned)w; }
namespace pg8 {
constexpr int BM = 256, BK = 64, HALF = 128, HTB = HALF * BK * 2  , STAGE_BYTES = 8 * HTB;
__host__ __device__ __forceinline__ int lds_byte(int r, int c) { const int st = (r >> 4) * 2 + (c >> 5), rr = r & 15, cc = c & 31, ob = rr * 64 + cc * 2; return st * 1024 + (ob ^ (((ob >> 9) & 1) << 5)); }
__host__ __device__ __forceinline__ void stage_rc(int b, int& R, int& C) { const int st = b / 1024, sb = b % 1024, swz = sb ^ (((sb >> 9) & 1) << 5); R = (st >> 1) * 16 + swz / 64; C = (st & 1) * 32 + (swz % 64) / 2; }
__host__ __device__ __forceinline__ int perm32(int rho) { const int n = rho >> 4, i = rho & 15; return 8 * (i >> 2) + 4 * n + (i & 3); }

struct Unit { const char* A; const char* B; const int* gidx; int pm, pn, aux, aux2; };
struct Gemm { int lda, ldb, K; int sw = 0x7f7f7f7f, sx = 0x7f7f7f7f; };
__host__ __device__ __forceinline__ int lds_byte_b(int r, int bc) { const int st = (r >> 4) * 2 + (bc >> 6), ob = (r & 15) * 64 + (bc & 63); return st * 1024 + (ob ^ (((ob >> 9) & 1) << 5)); }

template <class Epi, class Sched, bool GATHER = false, bool FP8 = false, bool ALIGN_EPI = true, bool SP2 = true>
__device__ __forceinline__ void gemm_phase(LAS unsigned char* lds, const Gemm g, const Sched& S, const Epi& E, int wid) {
    const int lane = lane_id_v(), tid = wid * 64 + lane, wr = wid >> 2, wc = wid & 3, fr = lane & 15, fq = lane >> 4;
    int K = g.K; asm volatile("" : "+s"(K));
    const int nt = K / BK;
    unsigned voffA[2], voffA1[2], voffB[2];
    int gR[2], gC[2];
#pragma unroll
    for (int i = 0; i < 2; ++i) { int R, C; stage_rc(tid * 16 + i * 8192, R, C); gR[i] = R; gC[i] = C * 2;
        voffA[i] = (unsigned)(R * g.lda + C * 2); voffA1[i] = voffA[i]; voffB[i] = (unsigned)(R * g.ldb + C * 2); }
    unsigned nvA[2] = {0u, 0u}, nvA1[2] = {0u, 0u};
    const size_t kstep = (size_t)(BK * 2);
    const size_t hstepA = GATHER ? 0 : (size_t)HALF * g.lda, hstepB = (size_t)HALF * g.ldb;
    const unsigned ldsw = (unsigned)wid * 1024u;
    const int aoff = FP8 ? lds_byte_b(wr * 64 + fr, fq * 32) : lds_byte(wr * 64 + fr, fq * 8), boff = FP8 ? lds_byte_b(wc * 32 + fr, fq * 32) : lds_byte(wc * 32 + fr, fq * 8);
    constexpr int KOFF = FP8 ? 16 : 1024;
    const int sw_ = g.sw, sx_ = g.sx;
#define PG8_SA(b, h) (((b) * 2 + (h)) * HTB)
#define PG8_SB(b, h) ((4 + (b) * 2 + (h)) * HTB)
#define PG8_STAGE(bufoff, gbase, voff) do { _Pragma("unroll") for (int _i = 0; _i < 2; ++_i) \
        __builtin_amdgcn_global_load_lds((const unsigned*)((const char*)(gbase) + (voff)[_i]), (LAS unsigned*)(lds + (bufoff) + ldsw + _i * 8192), 16, 0, 0); } while (0)
#define PG8_LDA(dst, b, h) do { _Pragma("unroll") for (int m = 0; m < 4; ++m) { const v4i lo_ = *(const LAS v4i*)(lds + PG8_SA(b, h) + aoff + m * 2048), hi_ = *(const LAS v4i*)(lds + PG8_SA(b, h) + aoff + m * 2048 + KOFF); \
        dst[m] = __builtin_shufflevector(lo_, hi_, 0, 1, 2, 3, 4, 5, 6, 7); } } while (0)
#define PG8_LDB(dst, b, h) do { _Pragma("unroll") for (int n = 0; n < 2; ++n) { const v4i lo_ = *(const LAS v4i*)(lds + PG8_SB(b, h) + boff + n * 2048), hi_ = *(const LAS v4i*)(lds + PG8_SB(b, h) + boff + n * 2048 + KOFF); \
        dst[n] = __builtin_shufflevector(lo_, hi_, 0, 1, 2, 3, 4, 5, 6, 7); } } while (0)
#define PG8_H0(x) __builtin_bit_cast(bf16x8, __builtin_shufflevector((x), (x), 0, 1, 2, 3))
#define PG8_H1(x) __builtin_bit_cast(bf16x8, __builtin_shufflevector((x), (x), 4, 5, 6, 7))
#define PG8_MMA(ai, bj, At, Bt) do { __builtin_amdgcn_s_setprio(1); _Pragma("unroll") for (int m = 0; m < 4; ++m) _Pragma("unroll") for (int n = 0; n < 2; ++n) { \
        if constexpr (FP8) asm volatile("v_mfma_scale_f32_16x16x128_f8f6f4 %0, %1, %2, %0, %3, %4 op_sel_hi:[0,0,0]" : "+v"(acc[ai][bj][m][n]) : "v"(Bt[n]), "v"(At[m]), "v"(sw_), "v"(sx_)); \
        else { acc[ai][bj][m][n] = __builtin_amdgcn_mfma_f32_16x16x32_bf16(PG8_H0(Bt[n]), PG8_H0(At[m]), acc[ai][bj][m][n], 0, 0, 0); \
               acc[ai][bj][m][n] = __builtin_amdgcn_mfma_f32_16x16x32_bf16(PG8_H1(Bt[n]), PG8_H1(At[m]), acc[ai][bj][m][n], 0, 0, 0); } } \
        __builtin_amdgcn_s_setprio(0); } while (0)
#define PG8_WAIT_V(n) asm volatile("s_waitcnt vmcnt(" #n ")" ::: "memory")
#define PG8_WAIT_L(n) asm volatile("s_waitcnt lgkmcnt(" #n ")" ::: "memory")
#define PG8_BAR __builtin_amdgcn_s_barrier()
#define PG8_SCHED __builtin_amdgcn_sched_barrier(0)
    Unit cur, nxt; int ui = 0;
    if (!S.next(0, cur)) return;
    f32x4 acc[2][2][4][2];
#pragma unroll
    for (int a = 0; a < 2; ++a)
#pragma unroll
        for (int b = 0; b < 2; ++b)
#pragma unroll
            for (int m = 0; m < 4; ++m)
#pragma unroll
                for (int n = 0; n < 2; ++n) acc[a][b][m][n] = (f32x4){0.f, 0.f, 0.f, 0.f};
    v8i At[4], B0[2], B1[2];
    const char* cA = cur.A; const char* cB = cur.B;
    if constexpr (GATHER) {
#pragma unroll
        for (int i = 0; i < 2; ++i) { voffA[i] = (unsigned)(cur.gidx[gR[i]] * g.lda + gC[i]); voffA1[i] = (unsigned)(cur.gidx[HALF + gR[i]] * g.lda + gC[i]); } }
    if constexpr (SP2) {
        PG8_STAGE(PG8_SB(0, 0), cB, voffB); PG8_STAGE(PG8_SB(0, 1), cB + hstepB, voffB); PG8_STAGE(PG8_SA(0, 0), cA, voffA); PG8_STAGE(PG8_SA(0, 1), cA + hstepA, voffA1);
        if (wr == 1) PG8_BAR;
        PG8_WAIT_V(2); PG8_BAR;
        PG8_STAGE(PG8_SB(1, 0), cB + kstep, voffB); PG8_STAGE(PG8_SA(1, 0), cA + kstep, voffA); PG8_STAGE(PG8_SB(1, 1), cB + hstepB + kstep, voffB);
        PG8_WAIT_V(6); PG8_BAR;
    } else {
        PG8_STAGE(PG8_SB(0, 0), cB, voffB); PG8_STAGE(PG8_SA(0, 0), cA, voffA); PG8_STAGE(PG8_SB(0, 1), cB + hstepB, voffB); PG8_STAGE(PG8_SA(0, 1), cA + hstepA, voffA1);
        if (wr == 1) PG8_BAR;
        PG8_WAIT_V(4); PG8_BAR;
        PG8_STAGE(PG8_SB(1, 0), cB + kstep, voffB); PG8_STAGE(PG8_SA(1, 0), cA + kstep, voffA); PG8_STAGE(PG8_SB(1, 1), cB + hstepB + kstep, voffB);
        PG8_WAIT_V(6); PG8_BAR;
    }
    for (;;) {
        const bool has_next = S.next(ui + 1, nxt);
        const char* nA = has_next ? nxt.A : cA; const char* nB = has_next ? nxt.B : cB;
        if constexpr (GATHER) {
#pragma unroll
            for (int i = 0; i < 2; ++i) { nvA[i] = has_next ? (unsigned)(nxt.gidx[gR[i]] * g.lda + gC[i]) : voffA[i]; nvA1[i] = has_next ? (unsigned)(nxt.gidx[HALF + gR[i]] * g.lda + gC[i]) : voffA1[i]; } }
        for (int t = 0; t < nt; t += 2) {
            const bool last = (t == nt - 2);
            const char* a1 = cA + (size_t)(t + 1) * kstep;
            const char* a2 = last ? nA : cA + (size_t)(t + 2) * kstep; const char* b2 = last ? nB : cB + (size_t)(t + 2) * kstep;
            const char* a3 = a2 + kstep; const char* b3 = b2 + kstep;
            unsigned vA2[2], vA21[2];
#pragma unroll
            for (int i = 0; i < 2; ++i) { vA2[i] = (GATHER && last) ? nvA[i] : voffA[i]; vA21[i] = (GATHER && last) ? nvA1[i] : voffA1[i]; }
            if constexpr (SP2) {
            PG8_LDB(B0, 0, 0); PG8_LDB(B1, 0, 1); PG8_SCHED; PG8_LDA(At, 0, 0); PG8_STAGE(PG8_SA(1, 1), a1 + hstepA, voffA1);
            PG8_WAIT_V(8); PG8_WAIT_L(0); PG8_BAR; PG8_MMA(0, 0, At, B0); PG8_MMA(0, 1, At, B1); PG8_BAR; PG8_SCHED;
            PG8_LDA(At, 0, 1); PG8_STAGE(PG8_SB(0, 0), b2, voffB); PG8_STAGE(PG8_SB(0, 1), b2 + hstepB, voffB); PG8_STAGE(PG8_SA(0, 0), a2, vA2);
            PG8_WAIT_V(8); PG8_WAIT_L(0); PG8_BAR; PG8_MMA(1, 0, At, B0); PG8_MMA(1, 1, At, B1); PG8_BAR; PG8_SCHED;
            PG8_LDB(B0, 1, 0); PG8_LDB(B1, 1, 1); PG8_SCHED; PG8_LDA(At, 1, 0); PG8_STAGE(PG8_SA(0, 1), a2 + hstepA, vA21);
            PG8_WAIT_V(8); PG8_WAIT_L(0); PG8_BAR; PG8_MMA(0, 0, At, B0); PG8_MMA(0, 1, At, B1); PG8_BAR; PG8_SCHED;
            PG8_LDA(At, 1, 1); PG8_STAGE(PG8_SB(1, 0), b3, voffB); PG8_STAGE(PG8_SB(1, 1), b3 + hstepB, voffB); PG8_STAGE(PG8_SA(1, 0), a3, vA2);
            PG8_WAIT_V(8); PG8_WAIT_L(0); PG8_BAR; PG8_MMA(1, 0, At, B0); PG8_MMA(1, 1, At, B1); PG8_BAR; PG8_SCHED;
            } else {
            PG8_LDB(B0, 0, 0); PG8_SCHED; PG8_LDA(At, 0, 0); PG8_STAGE(PG8_SA(1, 1), a1 + hstepA, voffA1);
            PG8_WAIT_L(8); PG8_BAR; PG8_WAIT_L(0); PG8_MMA(0, 0, At, B0); PG8_BAR; PG8_SCHED;
            PG8_LDB(B1, 0, 1); PG8_STAGE(PG8_SB(0, 0), b2, voffB);
            PG8_BAR; PG8_WAIT_L(0); PG8_MMA(0, 1, At, B1); PG8_BAR;
            PG8_LDA(At, 0, 1); PG8_STAGE(PG8_SA(0, 0), a2, vA2);
            PG8_BAR; PG8_WAIT_L(0); PG8_MMA(1, 0, At, B0); PG8_BAR; PG8_SCHED;
            PG8_STAGE(PG8_SB(0, 1), b2 + hstepB, voffB);
            PG8_WAIT_V(6); PG8_BAR; PG8_MMA(1, 1, At, B1); PG8_BAR;
            PG8_LDB(B0, 1, 0); PG8_SCHED; PG8_LDA(At, 1, 0); PG8_STAGE(PG8_SA(0, 1), a2 + hstepA, vA21);
            PG8_WAIT_L(8); PG8_BAR; PG8_WAIT_L(0); PG8_MMA(0, 0, At, B0); PG8_BAR; PG8_SCHED;
            PG8_LDB(B1, 1, 1); PG8_STAGE(PG8_SB(1, 0), b3, voffB);
            PG8_BAR; PG8_WAIT_L(0); PG8_MMA(0, 1, At, B1); PG8_BAR;
            PG8_LDA(At, 1, 1); PG8_STAGE(PG8_SA(1, 0), a3, vA2);
            PG8_BAR; PG8_WAIT_L(0); PG8_MMA(1, 0, At, B0); PG8_BAR; PG8_SCHED;
            PG8_STAGE(PG8_SB(1, 1), b3 + hstepB, voffB);
            PG8_WAIT_V(6); PG8_BAR; PG8_MMA(1, 1, At, B1); PG8_BAR;
            }
        }
        if constexpr (ALIGN_EPI) { if (wr == 0) PG8_BAR; }
        if constexpr (FP8) asm volatile("s_nop 15\n\ts_nop 15" ::: "memory");
        E(acc, cur, wr, wc, fr, fq);
        if (!has_next) break;
#pragma unroll
        for (int a = 0; a < 2; ++a)
#pragma unroll
            for (int b = 0; b < 2; ++b)
#pragma unroll
                for (int m = 0; m < 4; ++m)
#pragma unroll
                    for (int n = 0; n < 2; ++n) acc[a][b][m][n] = (f32x4){0.f, 0.f, 0.f, 0.f};
        cur = nxt; cA = nA; cB = nB; ++ui;
        if constexpr (GATHER) {
#pragma unroll
            for (int i = 0; i < 2; ++i) { voffA[i] = nvA[i]; voffA1[i] = nvA1[i]; } }
        if constexpr (ALIGN_EPI) { if (wr == 1) PG8_BAR; }
    }
    PG8_WAIT_V(0);
    if constexpr (!ALIGN_EPI) { if (wr == 0) PG8_BAR; }
    PG8_BAR;
#undef PG8_SA
#undef PG8_SB
#undef PG8_STAGE
#undef PG8_LDA
#undef PG8_LDB
#undef PG8_MMA
#undef PG8_H0
#undef PG8_H1
#undef PG8_WAIT_V
#undef PG8_WAIT_L
#undef PG8_BAR
#undef PG8_SCHED
}
}

#define XB_TMO      128
#define XB_XCNT(j)  (256  + 64 * (j))
#define XB_XSUB(j)  (1280 + 64 * (j))
#define XB_XGEN(j)  (2304 + 64 * (j))
#define XB_TOP      3328
#define XB_TOPGEN   3392
#define XCD_BAR_WORDS 3456
#define XB_SPIN_CAP (1u << 18)
__device__ __forceinline__ unsigned xb_ld(unsigned* p)              { return __hip_atomic_load(p, __ATOMIC_RELAXED, __HIP_MEMORY_SCOPE_AGENT); }
__device__ __forceinline__ unsigned xb_add(unsigned* p, unsigned v) { return __hip_atomic_fetch_add(p, v, __ATOMIC_RELAXED, __HIP_MEMORY_SCOPE_AGENT); }
__device__ __forceinline__ unsigned xb_xcc_id() { return (unsigned)__builtin_amdgcn_s_getreg((3 << 11) | 20) & 0xFu; }
#define XB_SPIN(cond, bar) do { unsigned _sp = 0; while (cond) { __builtin_amdgcn_s_sleep(1); \
    if ((++_sp & 255u) == 0u) { if (xb_ld(&(bar)[XB_TMO])) break; if (_sp > XB_SPIN_CAP) { atomicAdd(&(bar)[XB_TMO], 1u); break; } } } } while (0)
struct XcdBarrier { unsigned* bar; unsigned x; volatile LAS unsigned* st; };
__device__ __forceinline__ XcdBarrier xcd_barrier_post(unsigned* bar, volatile LAS unsigned* st) {
    XcdBarrier b; b.bar = bar; b.x = xb_xcc_id(); b.st = st;
    if (threadIdx.x == 0) (void)xb_add(&bar[XB_XCNT(b.x)], 1u);
    return b;
}
__device__ __forceinline__ void xcd_barrier_complete(unsigned* bar, unsigned x, unsigned& nloc, unsigned& nx) {
    const unsigned G = gridDim.x * gridDim.y * gridDim.z;
    unsigned sum, cnt, mine, sp = 0u;
    for (;;) {
        sum = 0u; cnt = 0u; mine = 0u;
#pragma unroll
        for (unsigned j = 0; j < 16; ++j) { const unsigned c = xb_ld(&bar[XB_XCNT(j)]); sum += c; cnt += (c > 0u) ? 1u : 0u; mine = (j == x) ? c : mine; }
        if (sum == G) break;
        __builtin_amdgcn_s_sleep(1);
        if ((++sp & 255u) == 0u) { if (xb_ld(&bar[XB_TMO])) break; if (sp > XB_SPIN_CAP) { atomicAdd(&bar[XB_TMO], 1u); break; } }
    }
    nloc = mine > 0u ? mine : 1u; nx = cnt > 0u ? cnt : 1u;
}
__device__ __forceinline__ void xcd_barrier(const XcdBarrier& b, int wave) {
    asm volatile("s_waitcnt vmcnt(0)" ::: "memory");
    __syncthreads();
    if (wave == 0 && lane_id_v() == 0) {
        unsigned* bar = b.bar;
        __builtin_amdgcn_s_waitcnt(0);
        unsigned nloc = b.st[0], nx = b.st[1];
        if (nloc == 0u) { xcd_barrier_complete(bar, b.x, nloc, nx); b.st[0] = nloc; b.st[1] = nx; }
        const unsigned old = xb_add(&bar[XB_XSUB(b.x)], 1u);
        const unsigned gen = old / nloc;
        if (old + 1u == (gen + 1u) * nloc) {
            __builtin_amdgcn_fence(__ATOMIC_RELEASE, "agent");
            asm volatile("s_waitcnt vmcnt(0)" ::: "memory");
            const unsigned og = xb_add(&bar[XB_TOP], 1u);
            const unsigned tg = og / nx;
            if (og + 1u == (tg + 1u) * nx) xb_add(&bar[XB_TOPGEN], 1u);
            else XB_SPIN(xb_ld(&bar[XB_TOPGEN]) == tg, bar);
            __builtin_amdgcn_fence(__ATOMIC_ACQUIRE, "agent");
            xb_add(&bar[XB_XGEN(b.x)], 1u);
            asm volatile("s_waitcnt vmcnt(0)" ::: "memory");
        } else {
            XB_SPIN(xb_ld(&bar[XB_XGEN(b.x)]) == gen, bar);
            __builtin_amdgcn_fence(__ATOMIC_ACQUIRE, "agent");
            asm volatile("s_waitcnt vmcnt(0)" ::: "memory");
        }
    }
    __syncthreads();
}

constexpr size_t MiB = 1u << 20;
constexpr size_t WS_CTL = 0, CTL_ZERO_BYTES = 1 * MiB;
constexpr int CW_TMO = 0, CW_BAR = 4096, CW_CNT = 16384;
constexpr size_t WS_TIDX = 1 * MiB, WS_TGATE = 2 * MiB, WS_TRANK = 3 * MiB, WS_TOKSLOT = 4 * MiB, WS_SLOTGATE = 5 * MiB, WS_WGBASE = 6 * MiB;
constexpr size_t WS_WRF = 7 * MiB, WS_SLOTTOK = 9 * MiB;
constexpr size_t WS_WGU = 16 * MiB;
constexpr size_t WS_WD = 144 * MiB;
constexpr size_t WS_WMISC = 208 * MiB;
constexpr size_t WS_RA = 272 * MiB, WS_RB = 544 * MiB, WS_RC = 816 * MiB, WS_RD = 944 * MiB, WS_END = 1024 * MiB;
constexpr size_t WS_WQ = WS_WMISC + 0 * MiB, WS_WK = WS_WMISC + 2 * MiB, WS_WV = WS_WMISC + 4 * MiB, WS_WOC = WS_WMISC + 6 * MiB;
constexpr size_t WS_X1 = WS_RA, WS_X1B = WS_RA + 128 * MiB, WS_QC = WS_RA + 192 * MiB;
constexpr size_t WS_PRE1 = WS_RB, WS_PM = WS_RB, WS_OC = WS_RB + 64 * MiB, WS_PRE2 = WS_RB + 128 * MiB;
constexpr size_t WS_X2 = WS_RC, WS_X2B = WS_RD;
constexpr size_t WS_MEMB = WS_RD, WS_KC = WS_RD + 8 * MiB, WS_VCT = WS_RD + 16 * MiB;
constexpr size_t WS_WIN = WS_WMISC + 8 * MiB, WS_WAO = WS_WMISC + 16 * MiB, WS_WGLU = WS_WMISC + 18 * MiB, WS_WOUT = WS_WMISC + 20 * MiB,
                 WS_BTS = WS_WMISC + 22 * MiB  , WS_BTST = WS_WMISC + 42 * MiB  , WS_ABARL = WS_WMISC + 50 * MiB;
constexpr size_t WS_XB = WS_RA, WS_QR = WS_RA + 64 * MiB, WS_MIX = WS_RA + 192 * MiB;
constexpr size_t WS_GA = WS_RB, WS_GS = WS_RB + 64 * MiB, WS_AO = WS_RB + 128 * MiB, WS_SG = WS_RB + 192 * MiB, WS_SST = WS_RB + 256 * MiB;
constexpr size_t WS_AS = WS_RC, WS_Z = WS_RC + 40 * MiB, WS_KR = WS_RC + 72 * MiB, WS_VR = WS_RC + 80 * MiB, WS_CS = WS_RC + 88 * MiB;
constexpr int MAXTILE256 = (NASSIGN + NE * 255) / 256 + 1;

constexpr int RING_BYTES = 131072, MISC_OFF = RING_BYTES, LDS_BYTES = 147456;
constexpr int NWAVES = 8;

struct Args {
    const float* in[33]; float* out; unsigned char* ws;
    unsigned long long mask;
};

__host__ __device__ __forceinline__ int sigma32(int q) { return 16 * ((q >> 2) & 1) + 4 * (q >> 3) + (q & 3); }
template <class PermFn, bool KSIG = false>
__device__ __forceinline__ void transpose_item(const float* W, int K, int N, bf16* WT, LAS float* scr, int item, int lane, const PermFn& perm) {
    const int nblk = N / 32, kb = item / nblk, nb = item % nblk, k0 = 64 * kb, n0 = 32 * nb;
#pragma unroll 8
    for (int i = 0; i < 32; ++i) { const int kk = 2 * i + (lane >> 5); const int ks = KSIG ? ((kk & 32) + sigma32(kk & 31)) : kk;
        scr[kk * 33 + (lane & 31)] = W[(size_t)(k0 + ks) * N + n0 + (lane & 31)]; }
    LDS_WAIT(); asm volatile("" ::: "memory");
    const int c = lane & 7;
#pragma unroll
    for (int j = 0; j < 4; ++j) { const int n = (lane >> 3) + 8 * j; const LAS float* s = scr + (8 * c) * 33 + n;
        v4u o; o.x = cvt_pk_bf16(s[0 * 33], s[1 * 33]); o.y = cvt_pk_bf16(s[2 * 33], s[3 * 33]); o.z = cvt_pk_bf16(s[4 * 33], s[5 * 33]); o.w = cvt_pk_bf16(s[6 * 33], s[7 * 33]);
        *(GAS v4u*)(WT + (size_t)perm(n0 + n) * K + k0 + 8 * c) = o; }
    LDS_WAIT(); asm volatile("" ::: "memory");
}
template <class PermFn>
__device__ __forceinline__ void transpose_item_q(const float* W, int K, int N, unsigned char* WT, LAS float* scr, int item, int lane, const PermFn& perm, float scale) {
    const int nblk = N / 32, kb = item / nblk, nb = item % nblk, k0 = 64 * kb, n0 = 32 * nb;
#pragma unroll 8
    for (int i = 0; i < 32; ++i) { const int kk = 2 * i + (lane >> 5); scr[kk * 33 + (lane & 31)] = W[(size_t)(k0 + kk) * N + n0 + (lane & 31)] * scale; }
    LDS_WAIT(); asm volatile("" ::: "memory");
    const int c = lane & 3;
#pragma unroll
    for (int j = 0; j < 2; ++j) { const int n = (lane >> 2) + 16 * j; const LAS float* s = scr + (16 * c) * 33 + n;
        v4u o; o.x = cvt4_fp8(s[0 * 33], s[1 * 33], s[2 * 33], s[3 * 33]); o.y = cvt4_fp8(s[4 * 33], s[5 * 33], s[6 * 33], s[7 * 33]);
        o.z = cvt4_fp8(s[8 * 33], s[9 * 33], s[10 * 33], s[11 * 33]); o.w = cvt4_fp8(s[12 * 33], s[13 * 33], s[14 * 33], s[15 * 33]);
        *(GAS v4u*)(WT + (size_t)perm(n0 + n) * K + k0 + 16 * c) = o; }
    LDS_WAIT(); asm volatile("" ::: "memory");
}
struct PermId { __device__ __forceinline__ int operator()(int n) const { return n; } };
struct PermGU { __device__ __forceinline__ int operator()(int n) const { const int ty = n & 1, lc = n >> 1, pn = lc >> 7, wc = (lc >> 5) & 3, fq = (lc >> 3) & 3, bj = (lc >> 2) & 1, j = lc & 3;
    return 256 * pn + 128 * bj + 32 * wc + 16 * ty + 4 * fq + j; } };

__device__ __forceinline__ int crow32(int r, int hi) { return (r & 3) + 8 * (r >> 2) + 4 * hi; }
__device__ __forceinline__ void phase_router(const Args& a, LAS unsigned char* lds, int wave) {
    unsigned char* ws = a.ws; const int lane = lane_id_v(), tid = wave * 64 + lane;
    LAS int* hist = (LAS int*)(lds + 65536);
    LAS float* tile = (LAS float*)(lds + wave * 8192);
    if (tid < 32) hist[tid] = 0;
    for (int i = blockIdx.x * 512 + tid; i < MAXTILE256 * 256; i += gridDim.x * 512) ((int*)(ws + WS_SLOTTOK))[i] = 0;
    __syncthreads();
    if (wave < 4) {
        const int tok0 = (blockIdx.x * 4 + wave) * 32, r32 = lane & 31, hi = lane >> 5;
        const float* xr = (const float*)(ws + WS_X2) + (size_t)(tok0 + r32) * D + hi * 8;
        const bf16x8* wh = (const bf16x8*)(ws + WS_WRF) + hi * 32 + r32;
        const bf16x8* wl = (const bf16x8*)(ws + WS_WRF + 65536) + hi * 32 + r32;
        f32x16 acc;
#pragma unroll
        for (int r = 0; r < 16; ++r) acc[r] = 0.f;
#pragma unroll 2
        for (int s = 0; s < 64; ++s) {
            const f32x4 v0 = *(const f32x4*)(xr + s * 16), v1 = *(const f32x4*)(xr + s * 16 + 4);
            v4u h, l;
            h.x = cvt_pk_bf16(v0[0], v0[1]); h.y = cvt_pk_bf16(v0[2], v0[3]); h.z = cvt_pk_bf16(v1[0], v1[1]); h.w = cvt_pk_bf16(v1[2], v1[3]);
            l.x = cvt_pk_bf16(v0[0] - bf_lo(h.x), v0[1] - bf_hi(h.x)); l.y = cvt_pk_bf16(v0[2] - bf_lo(h.y), v0[3] - bf_hi(h.y));
            l.z = cvt_pk_bf16(v1[0] - bf_lo(h.z), v1[1] - bf_hi(h.z)); l.w = cvt_pk_bf16(v1[2] - bf_lo(h.w), v1[3] - bf_hi(h.w));
            const bf16x8 ah = __builtin_bit_cast(bf16x8, h), al = __builtin_bit_cast(bf16x8, l);
            const bf16x8 bh = wh[s * 64], bl = wl[s * 64];
            acc = __builtin_amdgcn_mfma_f32_32x32x16_bf16(ah, bh, acc, 0, 0, 0);
            acc = __builtin_amdgcn_mfma_f32_32x32x16_bf16(ah, bl, acc, 0, 0, 0);
            acc = __builtin_amdgcn_mfma_f32_32x32x16_bf16(al, bh, acc, 0, 0, 0);
        }
        const float bias = a.in[26][r32];
#pragma unroll
        for (int r = 0; r < 16; ++r) tile[crow32(r, hi) * 33 + r32] = acc[r] + bias;
        LDS_WAIT(); asm volatile("" ::: "memory");
        if (lane < 32) {
            float lg[NE];
#pragma unroll
            for (int e = 0; e < NE; ++e) lg[e] = tile[lane * 33 + e];
            unsigned used = 0; float tv[4]; int ti[4];
#pragma unroll
            for (int k = 0; k < 4; ++k) { float best = -INFINITY; int bi = 0;
#pragma unroll
                for (int e = 0; e < NE; ++e) { const bool ok = !((used >> e) & 1u) && lg[e] > best; best = ok ? lg[e] : best; bi = ok ? e : bi; }
                used |= 1u << bi; tv[k] = best; ti[k] = bi; }
            float ex[4], s = 0.f;
#pragma unroll
            for (int k = 0; k < 4; ++k) { ex[k] = __expf(tv[k] - tv[0]); s += ex[k]; }
            const float is = 1.0f / s; int rk[4];
#pragma unroll
            for (int k = 0; k < 4; ++k) rk[k] = __hip_atomic_fetch_add(hist + ti[k], 1, __ATOMIC_RELAXED, __HIP_MEMORY_SCOPE_WORKGROUP);
            const int tok = tok0 + lane;
            *(int4*)(ws + WS_TIDX + (size_t)tok * 16) = make_int4(ti[0], ti[1], ti[2], ti[3]);
            *(float4*)(ws + WS_TGATE + (size_t)tok * 16) = make_float4(ex[0] * is, ex[1] * is, ex[2] * is, ex[3] * is);
            *(int4*)(ws + WS_TRANK + (size_t)tok * 16) = make_int4(rk[0], rk[1], rk[2], rk[3]);
        }
    }
    __syncthreads();
    if (tid < 32) { const int base = (int)__hip_atomic_fetch_add((unsigned*)(ws + WS_CTL) + CW_CNT + tid, (unsigned)hist[tid], RLX_AGENT);
        ((int*)(ws + WS_WGBASE))[blockIdx.x * 32 + tid] = base; }
}

__device__ __forceinline__ int expert_tiles(const Args& a, int lane, int& start_tile) {
    const int c = lane < 32 ? (int)__hip_atomic_load((unsigned*)(a.ws + WS_CTL) + CW_CNT + lane, RLX_AGENT) : 0;
    const int tiles = (c + 255) >> 8; int incl = tiles;
#pragma unroll
    for (int o = 1; o < 64; o <<= 1) { const int t = __shfl_up(incl, o); if (lane >= o) incl += t; }
    start_tile = incl - tiles;
    return __shfl(incl, 63);
}

__device__ __forceinline__ void phase_slots(const Args& a, int wave) {
    unsigned char* ws = a.ws; const int lane = lane_id_v(), tid = wave * 64 + lane;
    int start_tile; (void)expert_tiles(a, lane, start_tile);
    const int p = blockIdx.x * 512 + tid;
    const int e = ((const int*)(ws + WS_TIDX))[p], rank = ((const int*)(ws + WS_TRANK))[p]; const float gate = ((const float*)(ws + WS_TGATE))[p];
    const int st = __shfl(start_tile, e) * 256, base = ((const int*)(ws + WS_WGBASE))[blockIdx.x * 32 + e];
    const int slot = st + base + rank;
    ((int*)(ws + WS_TOKSLOT))[p] = slot; ((float*)(ws + WS_SLOTGATE))[slot] = gate;
    ((int*)(ws + WS_SLOTTOK))[slot] = p >> 2;
}

struct MoeOrder {
    int stl, ntot, sh, G, c; const char* A; const char* B; size_t a_tile, b_tile, b_exp; const int* gbase;
    __device__ __forceinline__ bool next(int i, pg8::Unit& u) const {
        const int x = c & 7, j = c >> 3, rpx = 32 >> sh;
        const int rt = (i * 8 + x) * rpx + (j >> sh), pn = j & ((1 << sh) - 1);
        if (rt >= ntot) return false;
        const int e = __popcll(__ballot(stl <= rt)) - 1;
        u.A = A + (size_t)rt * a_tile; u.B = B + (size_t)e * b_exp + (size_t)pn * b_tile; u.gidx = gbase ? gbase + rt * 256 : nullptr; u.pm = rt; u.pn = pn; u.aux = e; u.aux2 = 0; return true;
    }
};
struct EpiSwigluB {
    unsigned char* H; const float* bgu;
    __device__ __forceinline__ void operator()(const f32x4 (&acc)[2][2][4][2], const pg8::Unit& u, int wr, int wc, int fr, int fq) const {
        const int row0 = u.pm * 256 + wr * 64 + fr, lc0 = u.pn * 128 + wc * 32 + fq * 8;
        const float* bp = bgu + (size_t)u.aux * (2 * DE) + 2 * lc0;
        f32x4 b4[4];
#pragma unroll
        for (int i = 0; i < 4; ++i) b4[i] = *(const f32x4*)(bp + 4 * i);
#pragma unroll
        for (int ai = 0; ai < 2; ++ai)
#pragma unroll
            for (int m = 0; m < 4; ++m) {
                float hv[8];
#pragma unroll
                for (int bj = 0; bj < 2; ++bj)
#pragma unroll
                    for (int j = 0; j < 4; ++j) {
                        float g = acc[ai][bj][m][0][j] + b4[2 * bj + (j >> 1)][2 * (j & 1)], l = acc[ai][bj][m][1][j] + b4[2 * bj + (j >> 1)][2 * (j & 1) + 1];
                        g = fminf(g, 7.0f); l = fminf(fmaxf(l, -7.0f), 7.0f);
                        hv[4 * bj + j] = g * fast_sigmoid(1.702f * g) * (l + 1.0f); }
                v2u o; o.x = cvt4_fp8(hv[0], hv[1], hv[2], hv[3]); o.y = cvt4_fp8(hv[4], hv[5], hv[6], hv[7]);
                *(GAS v2u*)(H + (size_t)(row0 + ai * 128 + m * 16) * DE + lc0) = o; }
    }
};
struct EpiDownB {
    bf16* Y; const float* bd; const float* slot_gate;
    __device__ __forceinline__ void operator()(const f32x4 (&acc)[2][2][4][2], const pg8::Unit& u, int wr, int wc, int fr, int fq) const {
        const int row0 = u.pm * 256 + wr * 64 + fr, col0 = u.pn * 256 + wc * 32 + fq * 4;
        f32x4 bv[2][2];
#pragma unroll
        for (int bj = 0; bj < 2; ++bj)
#pragma unroll
            for (int n = 0; n < 2; ++n) bv[bj][n] = *(const f32x4*)(bd + (size_t)u.aux * D + col0 + bj * 128 + n * 16);
#pragma unroll
        for (int ai = 0; ai < 2; ++ai)
#pragma unroll
            for (int m = 0; m < 4; ++m) { const int row = row0 + ai * 128 + m * 16; const float gt = slot_gate[row];
#pragma unroll
                for (int bj = 0; bj < 2; ++bj)
#pragma unroll
                    for (int n = 0; n < 2; ++n) { const f32x4 v = (acc[ai][bj][m][n] + bv[bj][n]) * gt;
                        v2u o; o.x = cvt_pk_bf16(v[0], v[1]); o.y = cvt_pk_bf16(v[2], v[3]);
                        *(GAS v2u*)(Y + (size_t)row * D + col0 + bj * 128 + n * 16) = o; } }
    }
};

__device__ __forceinline__ void phase_combine(const Args& a, int wave) {
    unsigned char* ws = a.ws; const int lane = lane_id_v(); const bf16* Y = (const bf16*)(ws + WS_RA);
    const float* g3 = a.in[31]; const float* b3 = a.in[32];
    for (int tok = blockIdx.x * NWAVES + wave; tok < T; tok += gridDim.x * NWAVES) {
        const int myslot = ((const int*)(ws + WS_TOKSLOT))[tok * 4 + (lane & 3)];
        int sl[4];
#pragma unroll
        for (int k = 0; k < 4; ++k) sl[k] = __shfl(myslot, k);
        f32x4 v[4]; float s = 0.f;
#pragma unroll
        for (int j = 0; j < 4; ++j) { v[j] = *(const f32x4*)((const float*)(ws + WS_X2) + (size_t)tok * D + 4 * (64 * j + lane)) * ALPHA;
#pragma unroll
            for (int k = 0; k < 4; ++k) { const v2u w = *(const GAS v2u*)(Y + (size_t)sl[k] * D + 4 * (64 * j + lane));
                v[j][0] += bf_lo(w.x); v[j][1] += bf_hi(w.x); v[j][2] += bf_lo(w.y); v[j][3] += bf_hi(w.y); }
            s += (v[j][0] + v[j][1]) + (v[j][2] + v[j][3]); }
        const float mean = wave_sum(s) * (1.0f / D); float q = 0.f;
#pragma unroll
        for (int j = 0; j < 4; ++j) { v[j] = v[j] - mean; q += (v[j][0] * v[j][0] + v[j][1] * v[j][1]) + (v[j][2] * v[j][2] + v[j][3] * v[j][3]); }
        const float rstd = rsqrtf(wave_sum(q) * (1.0f / D) + LN_EPS);
#pragma unroll
        for (int j = 0; j < 4; ++j) { const int c = 4 * (64 * j + lane); const f32x4 gg = *(const f32x4*)(g3 + c), bb = *(const f32x4*)(b3 + c);
            *(f32x4*)(a.out + (size_t)tok * D + c) = v[j] * rstd * gg + bb; }
    }
}


struct GridOrder {
    int nM, nN, nwg, G, c; const char* A; const char* B; size_t a_tile, b_tile;
    __device__ __forceinline__ bool next(int i, pg8::Unit& u) const {
        const int L = i * G + c; if (L >= nwg) return false;
        int wgid = L; { const int q = nwg / 8, r = nwg % 8, xcd = wgid % 8, off = wgid / 8; wgid = (xcd < r ? xcd * (q + 1) : r * (q + 1) + (xcd - r) * q) + off; }
        const int nig = 8 * nN, gid = wgid / nig, fm = gid * 8, gsz = (nM - fm) < 8 ? (nM - fm) : 8;
        const int pm = fm + ((wgid % nig) % gsz), pn = (wgid % nig) / gsz;
        u.A = A + (size_t)pm * a_tile; u.B = B + (size_t)pn * b_tile; u.gidx = nullptr; u.pm = pm; u.pn = pn; u.aux = 0; u.aux2 = 0; return true;
    }
};
__device__ __forceinline__ GridOrder grid_order(int M, int N, int rot, const void* A, size_t lda_b, const void* B, size_t ldb_b) {
    GridOrder S; S.nM = M / 256; S.nN = N / 256; S.nwg = S.nM * S.nN; S.G = (int)gridDim.x; S.c = (int)((blockIdx.x + (unsigned)rot) % gridDim.x);
    S.A = (const char*)A; S.B = (const char*)B; S.a_tile = 256 * lda_b; S.b_tile = 256 * ldb_b; return S;
}
struct BhOrder {
    int G, c; const char* A; const char* B; size_t a_b, a_rt, a_h, b_b, b_h;
    __device__ __forceinline__ bool next(int i, pg8::Unit& u) const {
        const int L = i * G + c; if (L >= BATCH * NCH * (SEQ / 256)) return false;
        const int b = L >> 5, h = (L >> 3) & 3, rt = L & 7;
        u.A = A + (size_t)b * a_b + (size_t)rt * a_rt + (size_t)h * a_h; u.B = B + (size_t)b * b_b + (size_t)h * b_h; u.gidx = nullptr; u.pm = b * 8 + rt; u.pn = h; u.aux = 0; u.aux2 = 0; return true;
    }
};
struct EpiBf16N8 {
    bf16* O; int ldo; float scale;
    __device__ __forceinline__ void operator()(const f32x4 (&acc)[2][2][4][2], const pg8::Unit& u, int wr, int wc, int fr, int fq) const {
        const int row0 = u.pm * 256 + wr * 64 + fr, col0 = u.pn * 256 + wc * 32 + fq * 8;
#pragma unroll
        for (int ai = 0; ai < 2; ++ai)
#pragma unroll
            for (int m = 0; m < 4; ++m) { bf16* rowp = O + (size_t)(row0 + ai * 128 + m * 16) * ldo + col0;
#pragma unroll
                for (int bj = 0; bj < 2; ++bj) { const f32x4 v0 = acc[ai][bj][m][0] * scale, v1 = acc[ai][bj][m][1] * scale;
                    v4u w; w.x = cvt_pk_bf16(v0[0], v0[1]); w.y = cvt_pk_bf16(v0[2], v0[3]); w.z = cvt_pk_bf16(v1[0], v1[1]); w.w = cvt_pk_bf16(v1[2], v1[3]);
                    *(GAS v4u*)(rowp + bj * 128) = w; } }
    }
};
struct EpiResF32 {
    float* C; const float* res;
    __device__ __forceinline__ void operator()(const f32x4 (&acc)[2][2][4][2], const pg8::Unit& u, int wr, int wc, int fr, int fq) const {
        const int row0 = u.pm * 256 + wr * 64 + fr, col0 = u.pn * 256 + wc * 32 + fq * 4;
#pragma unroll
        for (int ai = 0; ai < 2; ++ai)
#pragma unroll
            for (int m = 0; m < 4; ++m) { const size_t ro = (size_t)(row0 + ai * 128 + m * 16) * D + col0;
#pragma unroll
                for (int bj = 0; bj < 2; ++bj)
#pragma unroll
                    for (int n = 0; n < 2; ++n) { const size_t o = ro + bj * 128 + n * 16; const f32x4 r = *(const f32x4*)(res + o);
                        *(f32x4*)(C + o) = r * ALPHA + acc[ai][bj][m][n]; } }
    }
};
struct EpiSoftmax {
    bf16* O; int ldo; LAS f32x2* X;
    __device__ __forceinline__ void operator()(f32x4 (&acc)[2][2][4][2], const pg8::Unit& u, int wr, int wc, int fr_, int fq_) const {
        const int l_ = lane_id_v(), fr = l_ & 15, fq = l_ >> 4;
#pragma unroll
        for (int ai = 0; ai < 2; ++ai)
#pragma unroll
            for (int m = 0; m < 4; ++m) {
                float mx = -INFINITY;
#pragma unroll
                for (int bj = 0; bj < 2; ++bj)
#pragma unroll
                    for (int n = 0; n < 2; ++n)
#pragma unroll
                        for (int j = 0; j < 4; ++j) mx = fmaxf(mx, acc[ai][bj][m][n][j]);
                mx = fmaxf(mx, __shfl_xor(mx, 16)); mx = fmaxf(mx, __shfl_xor(mx, 32));
                float s = 0.f;
#pragma unroll
                for (int bj = 0; bj < 2; ++bj)
#pragma unroll
                    for (int n = 0; n < 2; ++n)
#pragma unroll
                        for (int j = 0; j < 4; ++j) { const float p = __builtin_amdgcn_exp2f((acc[ai][bj][m][n][j] - mx) * 1.4426950408889634f); acc[ai][bj][m][n][j] = p; s += p; }
                s += __shfl_xor(s, 16); s += __shfl_xor(s, 32);
                if (fq == 0) X[(ai * 128 + wr * 64 + m * 16 + fr) * 4 + wc] = (f32x2){mx, s};
                __builtin_amdgcn_sched_barrier(0);
            }
        LDS_WAIT(); __builtin_amdgcn_s_barrier(); asm volatile("" ::: "memory");
        const int row0 = u.pm * 256 + wr * 64 + fr, col0 = u.pn * 256 + wc * 32 + fq * 8;
#pragma unroll
        for (int ai = 0; ai < 2; ++ai)
#pragma unroll
            for (int m = 0; m < 4; ++m) {
                const int rl = ai * 128 + wr * 64 + m * 16 + fr;
                const f32x2 x0 = X[rl * 4 + 0], x1 = X[rl * 4 + 1], x2 = X[rl * 4 + 2], x3 = X[rl * 4 + 3];
                const float M = fmaxf(fmaxf(x0.x, x1.x), fmaxf(x2.x, x3.x));
                const float L = x0.y * __builtin_amdgcn_exp2f((x0.x - M) * 1.4426950408889634f) + x1.y * __builtin_amdgcn_exp2f((x1.x - M) * 1.4426950408889634f)
                              + x2.y * __builtin_amdgcn_exp2f((x2.x - M) * 1.4426950408889634f) + x3.y * __builtin_amdgcn_exp2f((x3.x - M) * 1.4426950408889634f);
                const float mown = wc == 0 ? x0.x : wc == 1 ? x1.x : wc == 2 ? x2.x : x3.x;
                const float sc = __builtin_amdgcn_exp2f((mown - M) * 1.4426950408889634f) / L;
                bf16* rowp = O + (size_t)(row0 + ai * 128 + m * 16) * ldo + col0;
#pragma unroll
                for (int bj = 0; bj < 2; ++bj) { const f32x4 v0 = acc[ai][bj][m][0] * sc, v1 = acc[ai][bj][m][1] * sc;
                    v4u w; w.x = cvt_pk_bf16(v0[0], v0[1]); w.y = cvt_pk_bf16(v0[2], v0[3]); w.z = cvt_pk_bf16(v1[0], v1[1]); w.w = cvt_pk_bf16(v1[2], v1[3]);
                    *(GAS v4u*)(rowp + bj * 128) = w; }
                __builtin_amdgcn_sched_barrier(0); }
        LDS_WAIT();
    }
};

__device__ __forceinline__ void phase_ln(const float* pre, const float* gam, const float* bet, float* outf, bf16* outb, unsigned char* outq, int wave) {
    const int lane = lane_id_v();
    for (int row = blockIdx.x * NWAVES + wave; row < T; row += gridDim.x * NWAVES) {
        f32x4 v[4]; float s = 0.f;
#pragma unroll
        for (int j = 0; j < 4; ++j) { v[j] = *(const f32x4*)(pre + (size_t)row * D + 4 * (64 * j + lane)); s += (v[j][0] + v[j][1]) + (v[j][2] + v[j][3]); }
        const float mean = wave_sum(s) * (1.0f / D); float q = 0.f;
#pragma unroll
        for (int j = 0; j < 4; ++j) { v[j] = v[j] - mean; q += (v[j][0] * v[j][0] + v[j][1] * v[j][1]) + (v[j][2] * v[j][2] + v[j][3] * v[j][3]); }
        const float rstd = rsqrtf(wave_sum(q) * (1.0f / D) + LN_EPS);
#pragma unroll
        for (int j = 0; j < 4; ++j) { const int c = 4 * (64 * j + lane); const f32x4 gg = *(const f32x4*)(gam + c), bb = *(const f32x4*)(bet + c);
            const f32x4 o = v[j] * rstd * gg + bb;
            if (outf) *(f32x4*)(outf + (size_t)row * D + c) = o;
            if (outb) { v2u w; w.x = cvt_pk_bf16(o[0], o[1]); w.y = cvt_pk_bf16(o[2], o[3]); *(GAS v2u*)(outb + (size_t)row * D + c) = w; }
            if (outq) *(GAS unsigned*)(outq + (size_t)row * D + c) = cvt4_fp8(o[0], o[1], o[2], o[3]); }
    }
}
__device__ __forceinline__ void cvt_rows(const float* src, bf16* dst, size_t n, int lane, int wave) {
    const size_t stride = (size_t)gridDim.x * NWAVES * 64 * 8;
    for (size_t i = ((size_t)(blockIdx.x * NWAVES + wave) * 64 + lane) * 8; i < n; i += stride) {
        const f32x4 v0 = *(const f32x4*)(src + i), v1 = *(const f32x4*)(src + i + 4);
        v4u o; o.x = cvt_pk_bf16(v0[0], v0[1]); o.y = cvt_pk_bf16(v0[2], v0[3]); o.z = cvt_pk_bf16(v1[0], v1[1]); o.w = cvt_pk_bf16(v1[2], v1[3]);
        *(GAS v4u*)(dst + i) = o; }
}

constexpr float LOG2E = 1.4426950408889634f;
constexpr int SSM_L = 32, SSM_NCH = SEQ / SSM_L  , SSM_ROWS = BATCH * SSM_NCH  , SSM_K = SSM_L * SSM_H + 2 * SSM_P  ;

struct PermWin { __device__ __forceinline__ int operator()(int n) const { if (n >= O_V) return n; const int d = n & 63; return (n & ~63) + 2 * (d & 31) + (d >> 5); } };
template <int TY> struct PermGlu { __device__ __forceinline__ int operator()(int lc) const { const int pn = lc >> 7, wc = (lc >> 5) & 3, fq = (lc >> 3) & 3, bj = (lc >> 2) & 1, j = lc & 3;
    return 256 * pn + 128 * bj + 32 * wc + 16 * TY + 4 * fq + j; } };

__device__ __forceinline__ float gelu_tanh_f(float x) {
    const float u = 0.7978845608028654f * (x + 0.044715f * x * x * x);
    const float e = __builtin_amdgcn_exp2f(2.0f * LOG2E * u);
    return x * (1.0f - __builtin_amdgcn_rcpf(e + 1.0f));
}

struct EpiInproj {
    bf16 *QR, *KR, *VR, *AS, *GA, *GS; const float* cs;
    __device__ __forceinline__ static void rot(f32x4& v, const f32x4 c) { const float a0 = v[0] * c[0] - v[1] * c[1], a1 = v[1] * c[0] + v[0] * c[1], a2 = v[2] * c[2] - v[3] * c[3], a3 = v[3] * c[2] + v[2] * c[3]; v = (f32x4){a0, a1, a2, a3}; }
    __device__ __forceinline__ void operator()(const f32x4 (&acc)[2][2][4][2], const pg8::Unit& u, int wr, int wc, int fr, int fq) const {
        const int pn = u.pn, row0 = u.pm * 256 + wr * 64 + fr;
        if (pn < 5) {
            const float qs = pn < 4 ? 0.125f * LOG2E : 1.0f;
#pragma unroll
            for (int ai = 0; ai < 2; ++ai)
#pragma unroll
                for (int m = 0; m < 4; ++m) { const int row = row0 + ai * 128 + m * 16;
                    const float* cp = cs + (size_t)row * 64 + 2 * (16 * (wc & 1) + 2 * fq);
#pragma unroll
                    for (int bj = 0; bj < 2; ++bj) { f32x4 v0 = acc[ai][bj][m][0], v1 = acc[ai][bj][m][1];
                        const bool isv = (pn == 4) && (bj == 1);
                        if (!isv) { const f32x4 c0 = *(const f32x4*)cp, c1 = *(const f32x4*)(cp + 16); rot(v0, c0); rot(v1, c1); v0 = v0 * qs; v1 = v1 * qs; }
                        v4u w; w.x = cvt_pk_bf16(v0[0], v0[1]); w.y = cvt_pk_bf16(v0[2], v0[3]); w.z = cvt_pk_bf16(v1[0], v1[1]); w.w = cvt_pk_bf16(v1[2], v1[3]);
                        bf16* dst = pn < 4 ? QR + (size_t)row * QW + 256 * pn + 128 * bj + 32 * wc + 8 * fq : (bj == 0 ? KR : VR) + (size_t)row * KVW + 32 * wc + 8 * fq;
                        *(GAS v4u*)dst = w; } }
        } else if (pn < 7) {
#pragma unroll
            for (int ai = 0; ai < 2; ++ai)
#pragma unroll
                for (int m = 0; m < 4; ++m) { const int row = row0 + ai * 128 + m * 16, b = row >> 11, t = row & (SEQ - 1);
                    const size_t rbase = ((size_t)(b * SSM_NCH + (t >> 5)) * SSM_K + (t & 31) * 16 + 4 * fq);
#pragma unroll
                    for (int bj = 0; bj < 2; ++bj)
#pragma unroll
                        for (int n = 0; n < 2; ++n) { const int g = 16 * (pn - 5) + 8 * bj + 2 * wc + n; const f32x4 v = acc[ai][bj][m][n];
                            v2u w; w.x = cvt_pk_bf16(v[0], v[1]); w.y = cvt_pk_bf16(v[2], v[3]);
                            *(GAS v2u*)(AS + (size_t)g * SSM_ROWS * SSM_K + rbase) = w; } }
        } else {
            bf16* base = pn < 11 ? GA : GS; const int cb = 256 * ((pn - 7) & 3);
#pragma unroll
            for (int ai = 0; ai < 2; ++ai)
#pragma unroll
                for (int m = 0; m < 4; ++m) { const int row = row0 + ai * 128 + m * 16;
#pragma unroll
                    for (int bj = 0; bj < 2; ++bj) { const f32x4 v0 = acc[ai][bj][m][0], v1 = acc[ai][bj][m][1];
                        v4u w; w.x = cvt_pk_bf16(fast_sigmoid(v0[0]), fast_sigmoid(v0[1])); w.y = cvt_pk_bf16(fast_sigmoid(v0[2]), fast_sigmoid(v0[3]));
                        w.z = cvt_pk_bf16(fast_sigmoid(v1[0]), fast_sigmoid(v1[1])); w.w = cvt_pk_bf16(fast_sigmoid(v1[2]), fast_sigmoid(v1[3]));
                        *(GAS v4u*)(base + (size_t)row * D + cb + 128 * bj + 32 * wc + 8 * fq) = w; } }
        }
    }
};

constexpr int AT_KSTR = 144, AT_VSTR = 328, AT_VOFF = 160 * AT_KSTR;
__device__ __forceinline__ void phase_attn(const Args& a, LAS unsigned char* lds, int wave, const bf16* QR, const bf16* KR, const bf16* VR, bf16* AO) {
    const int lane = lane_id_v(), tid = wave * 64 + lane, r32 = lane & 31, hi = lane >> 5;
    const int nunits = BATCH * NKVH * (SEQ / 32);
    for (int L = blockIdx.x; L < nunits; L += gridDim.x) {
        const int b = L >> 7, kvh = (L >> 6) & 1, q0 = (L & 63) * 32;
        const size_t tok0 = (size_t)b * SEQ;
        for (int c = tid; c < 160 * 8; c += NWAVES * 64) {
            const int key = c >> 3, ch = c & 7, kpos = q0 - 128 + key, kp = kpos < 0 ? 0 : kpos;
            const v4u kv = *(const GAS v4u*)(KR + (tok0 + kp) * KVW + kvh * 64 + ch * 8);
            const v4u vv = *(const GAS v4u*)(VR + (tok0 + kp) * KVW + kvh * 64 + ch * 8);
            *(LAS v4u*)(lds + key * AT_KSTR + ch * 16) = kv;
            LAS bf16* vt = (LAS bf16*)(lds + AT_VOFF + (ch * 8) * AT_VSTR + key * 2);
            vt[0 * (AT_VSTR / 2)] = (bf16)(vv.x & 0xffffu); vt[1 * (AT_VSTR / 2)] = (bf16)(vv.x >> 16);
            vt[2 * (AT_VSTR / 2)] = (bf16)(vv.y & 0xffffu); vt[3 * (AT_VSTR / 2)] = (bf16)(vv.y >> 16);
            vt[4 * (AT_VSTR / 2)] = (bf16)(vv.z & 0xffffu); vt[5 * (AT_VSTR / 2)] = (bf16)(vv.z >> 16);
            vt[6 * (AT_VSTR / 2)] = (bf16)(vv.w & 0xffffu); vt[7 * (AT_VSTR / 2)] = (bf16)(vv.w >> 16);
        }
        const int hq = kvh * 8 + wave;
        bf16x8 qf[4];
#pragma unroll
        for (int s = 0; s < 4; ++s) qf[s] = *(const bf16x8*)(QR + (tok0 + q0 + r32) * QW + hq * 64 + s * 16 + hi * 8);
        __syncthreads();
        f32x16 sc[5];
#pragma unroll
        for (int kb = 0; kb < 5; ++kb) {
            f32x16 acc;
#pragma unroll
            for (int r = 0; r < 16; ++r) acc[r] = 0.f;
#pragma unroll
            for (int s = 0; s < 4; ++s) { const bf16x8 kf = *(const LAS bf16x8*)(lds + (kb * 32 + r32) * AT_KSTR + (s * 16 + hi * 8) * 2);
                acc = __builtin_amdgcn_mfma_f32_32x32x16_bf16(kf, qf[s], acc, 0, 0, 0); }
            sc[kb] = acc;
        }
        const float sink = a.in[4][hq] * LOG2E;
        float mx = sink;
        const int kmin = 128 - q0;
#pragma unroll
        for (int kb = 0; kb < 5; ++kb)
#pragma unroll
            for (int r = 0; r < 16; ++r) { const int key = kb * 32 + (r & 3) + 8 * (r >> 2) + 4 * hi;
                bool ok = key >= kmin; if (kb == 0) ok = ok && (key > r32); if (kb == 4) ok = ok && (key - 128 <= r32);
                const float s = ok ? sc[kb][r] : -INFINITY; sc[kb][r] = s; mx = fmaxf(mx, s); }
        mx = fmaxf(mx, __shfl_xor(mx, 32));
        float ls = 0.f;
#pragma unroll
        for (int kb = 0; kb < 5; ++kb)
#pragma unroll
            for (int r = 0; r < 16; ++r) { const float p = __builtin_amdgcn_exp2f(sc[kb][r] - mx); sc[kb][r] = p; ls += p; }
        ls += __shfl_xor(ls, 32);
        ls += __builtin_amdgcn_exp2f(sink - mx);
        f32x16 o[2];
#pragma unroll
        for (int r = 0; r < 16; ++r) { o[0][r] = 0.f; o[1][r] = 0.f; }
#pragma unroll
        for (int kb = 0; kb < 5; ++kb)
#pragma unroll
            for (int s2 = 0; s2 < 2; ++s2) {
                v4u pk; pk.x = cvt_pk_bf16(sc[kb][8 * s2 + 0], sc[kb][8 * s2 + 1]); pk.y = cvt_pk_bf16(sc[kb][8 * s2 + 2], sc[kb][8 * s2 + 3]);
                pk.z = cvt_pk_bf16(sc[kb][8 * s2 + 4], sc[kb][8 * s2 + 5]); pk.w = cvt_pk_bf16(sc[kb][8 * s2 + 6], sc[kb][8 * s2 + 7]);
                const bf16x8 pf = __builtin_bit_cast(bf16x8, pk);
#pragma unroll
                for (int db = 0; db < 2; ++db) { const LAS unsigned char* vp = lds + AT_VOFF + (db * 32 + r32) * AT_VSTR + (kb * 32 + 16 * s2 + 4 * hi) * 2;
                    const v2u lo = *(const LAS v2u*)vp, hh = *(const LAS v2u*)(vp + 16);
                    const v4u av = {lo.x, lo.y, hh.x, hh.y};
                    o[db] = __builtin_amdgcn_mfma_f32_32x32x16_bf16(__builtin_bit_cast(bf16x8, av), pf, o[db], 0, 0, 0); }
            }
        const float inv = 1.0f / ls;
        bf16* op = AO + (tok0 + q0 + r32) * QW + hq * 64 + 4 * hi;
#pragma unroll
        for (int db = 0; db < 2; ++db)
#pragma unroll
            for (int g4 = 0; g4 < 4; ++g4) { v2u w; w.x = cvt_pk_bf16(o[db][4 * g4] * inv, o[db][4 * g4 + 1] * inv); w.y = cvt_pk_bf16(o[db][4 * g4 + 2] * inv, o[db][4 * g4 + 3] * inv);
                *(GAS v2u*)(op + db * 32 + 8 * g4) = w; }
        __syncthreads();
    }
}

__device__ __forceinline__ void ssm_precompute(const Args& a, LAS unsigned char* lds, int g, int wave, bf16* BTS, bf16* BTST, float* ABARL) {
    const int lane = lane_id_v(), tid = wave * 64 + lane;
    LAS f32x2* PW = (LAS f32x2*)lds;
    LAS f32x2* BB = (LAS f32x2*)(lds + 16896);
    LAS f32x2* CC = (LAS f32x2*)(lds + 16896 + 8192);
    LAS float* KT = (LAS float*)(lds + 16896 + 16384);
    const float dt = expf(a.in[8][g]);
    for (int i = tid; i < 33 * 64; i += 512) { const int d = i >> 6, p = i & 63; const float lr = a.in[6][g * 64 + p], li = a.in[7][g * 64 + p];
        const float mag = expf((float)d * (lr * dt)); float s, c; sincosf((float)d * (li * dt), &s, &c); PW[i] = (f32x2){mag * c, mag * s}; }
    for (int i = tid; i < 64 * 16; i += 512) { const int p = i >> 4; const float lr = a.in[6][g * 64 + p], li = a.in[7][g * 64 + p], th = li * dt;
        float s, c; sincosf(th, &s, &c); const float em1 = expm1f(lr * dt), sh = sinf(0.5f * th);
        const float xr = em1 * c - 2.0f * sh * sh, xi = (em1 + 1.0f) * s, den = lr * lr + li * li;
        const float fr = (xr * lr + xi * li) / den, fi = (xi * lr - xr * li) / den;
        const float br = a.in[9][(size_t)(g * 64) * 16 + i], bi = a.in[10][(size_t)(g * 64) * 16 + i];
        BB[i] = (f32x2){fr * br - fi * bi, fr * bi + fi * br}; }
    for (int i = tid; i < 16 * 64; i += 512) CC[i] = (f32x2){a.in[11][(size_t)g * 1024 + i], a.in[12][(size_t)g * 1024 + i]};
    __syncthreads();
    for (int i = tid; i < 32 * 256; i += 512) { const int d = i >> 8, ho = (i >> 4) & 15, hh = i & 15; float acc = 0.f;
        for (int p = 0; p < 64; ++p) { const f32x2 c = CC[ho * 64 + p], w = PW[d * 64 + p], bb = BB[p * 16 + hh];
            const float tr = c.x * w.x - c.y * w.y, ti = c.x * w.y + c.y * w.x; acc += tr * bb.x - ti * bb.y; }
        KT[i] = acc; }
    __syncthreads();
    for (int q = tid; q < 512 * (SSM_K / 8); q += 512) { const int n = q / (SSM_K / 8), k0 = (q % (SSM_K / 8)) * 8, i = n >> 4, ho = n & 15; float v[8];
        if (k0 < 512) { const int d = i - (k0 >> 4), h0 = k0 & 15;
#pragma unroll
            for (int e = 0; e < 8; ++e) v[e] = d >= 0 ? KT[((d < 0 ? 0 : d) * 16 + ho) * 16 + h0 + e] : 0.f; }
        else { const bool im = k0 >= 576; const int p0 = k0 - (im ? 576 : 512);
#pragma unroll
            for (int e = 0; e < 8; ++e) { const f32x2 c = CC[ho * 64 + p0 + e], w = PW[(i + 1) * 64 + p0 + e]; v[e] = im ? -(c.x * w.y + c.y * w.x) : (c.x * w.x - c.y * w.y); } }
        v4u o; o.x = cvt_pk_bf16(v[0], v[1]); o.y = cvt_pk_bf16(v[2], v[3]); o.z = cvt_pk_bf16(v[4], v[5]); o.w = cvt_pk_bf16(v[6], v[7]);
        *(GAS v4u*)(BTS + ((size_t)(g * 512 + n) * SSM_K + k0)) = o; }
    for (int q = tid; q < 256 * 64; q += 512) { const int n = q >> 6, k0 = (q & 63) * 8, j = k0 >> 4, h0 = k0 & 15, p = n & 63; float v[8];
        const f32x2 w = PW[(31 - j) * 64 + p];
#pragma unroll
        for (int e = 0; e < 8; ++e) { const f32x2 bb = BB[p * 16 + h0 + e]; const float re = w.x * bb.x - w.y * bb.y, im = w.x * bb.y + w.y * bb.x; v[e] = n < 64 ? re : (n < 128 ? im : 0.f); }
        v4u o; o.x = cvt_pk_bf16(v[0], v[1]); o.y = cvt_pk_bf16(v[2], v[3]); o.z = cvt_pk_bf16(v[4], v[5]); o.w = cvt_pk_bf16(v[6], v[7]);
        *(GAS v4u*)(BTST + ((size_t)(g * 256 + n) * 512 + k0)) = o; }
    if (tid < 64) { const f32x2 w = PW[32 * 64 + tid]; ABARL[(g * 64 + tid) * 2] = w.x; ABARL[(g * 64 + tid) * 2 + 1] = w.y; }
    __syncthreads();
}

struct SsmOrder {
    int G, c, npn; const char* A; const char* B; size_t b_g, b_tile;
    __device__ __forceinline__ bool next(int i, pg8::Unit& u) const {
        const int L = i * G + c; if (L >= SSM_G * 4 * npn) return false;
        const int g = L / (4 * npn), r = L % (4 * npn), rt = r / npn, pn = r % npn;
        u.A = A + (size_t)(g * 4 + rt) * 256 * (SSM_K * 2); u.B = B + (size_t)g * b_g + (size_t)pn * b_tile; u.gidx = nullptr; u.pm = g * 4 + rt; u.pn = pn; u.aux = g; u.aux2 = 0; return true;
    }
};
struct EpiState {
    float* S;
    __device__ __forceinline__ void operator()(const f32x4 (&acc)[2][2][4][2], const pg8::Unit& u, int wr, int wc, int fr, int fq) const {
        const int row0 = u.pm * 256 + wr * 64 + fr, col0 = wc * 32 + fq * 4;
#pragma unroll
        for (int ai = 0; ai < 2; ++ai)
#pragma unroll
            for (int m = 0; m < 4; ++m)
#pragma unroll
                for (int n = 0; n < 2; ++n) *(f32x4*)(S + (size_t)(row0 + ai * 128 + m * 16) * 128 + col0 + n * 16) = acc[ai][0][m][n];
    }
};
__device__ __forceinline__ void phase_ssmb(int wave, const float* S, const float* ABARL, bf16* AS) {
    const int lane = lane_id_v(), idx = (blockIdx.x * NWAVES + wave) * 64 + lane;
    if (idx >= BATCH * SSM_G * SSM_P) return;
    const int p = idx & 63, g = (idx >> 6) & 31, b = idx >> 11;
    const float ar = ABARL[(g * 64 + p) * 2], ai = ABARL[(g * 64 + p) * 2 + 1];
    float hr = 0.f, hi = 0.f;
#pragma unroll 8
    for (int c = 0; c < SSM_NCH; ++c) { const size_t row = (size_t)g * SSM_ROWS + b * SSM_NCH + c;
        AS[row * SSM_K + 512 + p] = (bf16)(cvt_pk_bf16(hr, 0.f) & 0xffffu); AS[row * SSM_K + 576 + p] = (bf16)(cvt_pk_bf16(hi, 0.f) & 0xffffu);
        const float sr = S[row * 128 + p], si = S[row * 128 + 64 + p];
        const float nr = ar * hr - ai * hi + sr, ni = ar * hi + ai * hr + si; hr = nr; hi = ni; }
}
struct EpiSsmOut {
    const bf16* AS; const float* dsk; bf16* Z;
    __device__ __forceinline__ void operator()(const f32x4 (&acc)[2][2][4][2], const pg8::Unit& u, int wr, int wc, int fr, int fq) const {
        const int g = u.aux, rbase = (u.pm & 3) * 256 + wr * 64 + fr;
        const f32x4 dk = *(const f32x4*)(dsk + 16 * g + 4 * fq);
#pragma unroll
        for (int ai = 0; ai < 2; ++ai)
#pragma unroll
            for (int m = 0; m < 4; ++m) { const int rg = rbase + ai * 128 + m * 16, b = rg >> 6, ch = rg & 63;
                const bf16* arow = AS + ((size_t)g * SSM_ROWS + rg) * SSM_K + 4 * fq;
#pragma unroll
                for (int bj = 0; bj < 2; ++bj)
#pragma unroll
                    for (int n = 0; n < 2; ++n) { const int i = 16 * u.pn + 8 * bj + 2 * wc + n;
                        const v2u uw = *(const GAS v2u*)(arow + i * 16);
                        const f32x4 uu = {bf_lo(uw.x), bf_hi(uw.x), bf_lo(uw.y), bf_hi(uw.y)};
                        const f32x4 y = acc[ai][bj][m][n] + dk * uu;
                        v2u w; w.x = cvt_pk_bf16(gelu_tanh_f(y[0]), gelu_tanh_f(y[1])); w.y = cvt_pk_bf16(gelu_tanh_f(y[2]), gelu_tanh_f(y[3]));
                        *(GAS v2u*)(Z + ((size_t)b * SEQ + ch * 32 + i) * SSMW + 16 * g + 4 * fq) = w; } }
    }
};
struct EpiGlu {
    const bf16* GS; bf16* SG;
    __device__ __forceinline__ void operator()(const f32x4 (&acc)[2][2][4][2], const pg8::Unit& u, int wr, int wc, int fr, int fq) const {
        const int row0 = u.pm * 256 + wr * 64 + fr, pb = 128 * u.pn + 32 * wc + 16 * (fq & 1) + 4 * (fq >> 1);
#pragma unroll
        for (int ai = 0; ai < 2; ++ai)
#pragma unroll
            for (int m = 0; m < 4; ++m) { const size_t ro = (size_t)(row0 + ai * 128 + m * 16) * D + pb;
#pragma unroll
                for (int bj = 0; bj < 2; ++bj) { const v2u gw = *(const GAS v2u*)(GS + ro + 8 * bj);
                    const f32x4 gs = {bf_lo(gw.x), bf_hi(gw.x), bf_lo(gw.y), bf_hi(gw.y)}; const f32x4 av = acc[ai][bj][m][0], bv = acc[ai][bj][m][1];
                    v2u w; w.x = cvt_pk_bf16(gs[0] * av[0] * fast_sigmoid(bv[0]), gs[1] * av[1] * fast_sigmoid(bv[1]));
                    w.y = cvt_pk_bf16(gs[2] * av[2] * fast_sigmoid(bv[2]), gs[3] * av[3] * fast_sigmoid(bv[3]));
                    *(GAS v2u*)(SG + ro + 8 * bj) = w; } }
    }
};
struct EpiMixB {
    const bf16* GA; const bf16* SG; bf16* MIX;
    __device__ __forceinline__ void operator()(const f32x4 (&acc)[2][2][4][2], const pg8::Unit& u, int wr, int wc, int fr, int fq) const {
        const int row0 = u.pm * 256 + wr * 64 + fr, col0 = u.pn * 256 + wc * 32 + fq * 8;
#pragma unroll
        for (int ai = 0; ai < 2; ++ai)
#pragma unroll
            for (int m = 0; m < 4; ++m) { const size_t ro = (size_t)(row0 + ai * 128 + m * 16) * D + col0;
#pragma unroll
                for (int bj = 0; bj < 2; ++bj) { const v4u g = *(const GAS v4u*)(GA + ro + bj * 128), s = *(const GAS v4u*)(SG + ro + bj * 128);
                    const f32x4 v0 = acc[ai][bj][m][0], v1 = acc[ai][bj][m][1];
                    v4u w; w.x = cvt_pk_bf16(bf_lo(g.x) * v0[0] + bf_lo(s.x), bf_hi(g.x) * v0[1] + bf_hi(s.x)); w.y = cvt_pk_bf16(bf_lo(g.y) * v0[2] + bf_lo(s.y), bf_hi(g.y) * v0[3] + bf_hi(s.y));
                    w.z = cvt_pk_bf16(bf_lo(g.z) * v1[0] + bf_lo(s.z), bf_hi(g.z) * v1[1] + bf_hi(s.z)); w.w = cvt_pk_bf16(bf_lo(g.w) * v1[2] + bf_lo(s.w), bf_hi(g.w) * v1[3] + bf_hi(s.w));
                    *(GAS v4u*)(MIX + ro + bj * 128) = w; } }
    }
};

__device__ __forceinline__ void phase_prologue(const Args& a, LAS unsigned char* lds, int wave) {
    unsigned char* ws = a.ws; const int lane = lane_id_v();
    LAS float* scr = (LAS float*)(lds + wave * 16384);
    const int gw = blockIdx.x * NWAVES + wave, NGW = gridDim.x * NWAVES;
    constexpr int I_SQ = (D / 64) * (D / 32);
    constexpr int I_GU = (D / 64) * (2 * DE / 32), I_D = (DE / 64) * (D / 32);
    constexpr int I_IN = (D / 64) * (INW / 32), I_GL = (SSMW / 64) * (D / 32);
    constexpr int N_SMALL = 6 * I_SQ + I_IN + 2 * I_GL;
    if (blockIdx.x < SSM_G) ssm_precompute(a, lds, (int)blockIdx.x, wave, (bf16*)(ws + WS_BTS), (bf16*)(ws + WS_BTST), (float*)(ws + WS_ABARL));
    for (int it = gw; it < N_SMALL + NE * (I_GU + I_D); it += NGW) {
        int r = it;
        if (r < I_IN) { transpose_item(a.in[3], D, INW, (bf16*)(ws + WS_WIN), scr, r, lane, PermWin{}); continue; } r -= I_IN;
        if (r < I_SQ) { transpose_item<PermId, true>(a.in[5], D, D, (bf16*)(ws + WS_WAO), scr, r, lane, PermId{}); continue; } r -= I_SQ;
        if (r < I_GL) { transpose_item(a.in[14], SSMW, D, (bf16*)(ws + WS_WGLU), scr, r, lane, PermGlu<0>{}); continue; } r -= I_GL;
        if (r < I_GL) { transpose_item(a.in[15], SSMW, D, (bf16*)(ws + WS_WGLU), scr, r, lane, PermGlu<1>{}); continue; } r -= I_GL;
        if (r < I_SQ) { transpose_item<PermId, true>(a.in[16], D, D, (bf16*)(ws + WS_WOUT), scr, r, lane, PermId{}); continue; } r -= I_SQ;
        if (r < I_SQ) { transpose_item(a.in[19], D, D, (bf16*)(ws + WS_WQ), scr, r, lane, PermId{}); continue; } r -= I_SQ;
        if (r < I_SQ) { transpose_item(a.in[20], D, D, (bf16*)(ws + WS_WK), scr, r, lane, PermId{}); continue; } r -= I_SQ;
        if (r < I_SQ) { transpose_item(a.in[21], D, D, (bf16*)(ws + WS_WV), scr, r, lane, PermId{}); continue; } r -= I_SQ;
        if (r < I_SQ) { transpose_item<PermId, true>(a.in[22], D, D, (bf16*)(ws + WS_WOC), scr, r, lane, PermId{}); continue; } r -= I_SQ;
        if (r < NE * I_GU) { const int e = r / I_GU, q = r % I_GU;
            transpose_item_q(a.in[27] + (size_t)e * D * 2 * DE, D, 2 * DE, (unsigned char*)(ws + WS_WGU) + (size_t)e * 2 * DE * D, scr, q, lane, PermGU{}, 16.0f); continue; } r -= NE * I_GU;
        { const int e = r / I_D, q = r % I_D;
            transpose_item_q(a.in[29] + (size_t)e * DE * D, DE, D, (unsigned char*)(ws + WS_WD) + (size_t)e * D * DE, scr, q, lane, PermId{}, 32.0f); }
    }
    cvt_rows(a.in[1], (bf16*)(ws + WS_MEMB), (size_t)BATCH * NMEM * D, lane, wave);
    cvt_rows(a.in[0], (bf16*)(ws + WS_XB), (size_t)T * D, lane, wave);
    { const int* pos = (const int*)a.in[2]; float* cs = (float*)(ws + WS_CS);
      for (int i = gw * 64 + lane; i < T * 32; i += NGW * 64) { const float inv = powf(10000.0f, -(float)(i & 31) / 32.0f); float s, c; sincosf((float)pos[i >> 5] * inv, &s, &c);
          *(f32x2*)(cs + 2 * (size_t)i) = (f32x2){c, s}; } }
    for (int i = gw * 64 + lane; i < D * NE; i += NGW * 64) {
        const int j = i & 7, col = (i >> 3) & 31, h = (i >> 8) & 1, s = i >> 9;
        const float w = a.in[25][(size_t)(16 * s + 8 * h + j) * NE + col];
        const unsigned hb = cvt_pk_bf16(w, 0.f) & 0xffffu; const unsigned lb = cvt_pk_bf16(w - __uint_as_float(hb << 16), 0.f) & 0xffffu;
        ((bf16*)(ws + WS_WRF))[i] = (bf16)hb; ((bf16*)(ws + WS_WRF + 65536))[i] = (bf16)lb;
    }
}

enum { PH_PRO = 0, PH_INPROJ = 1, PH_KV = 2, PH_ATTN = 3, PH_SSMA = 4, PH_SSMB = 5, PH_SSMC = 6, PH_GLU = 7, PH_AOUT = 8, PH_WOUT = 9, PH_LN1 = 10,
       PH_QC = 11, PH_S = 12, PH_PV = 13, PH_WOC = 14, PH_LN2 = 15, PH_ROUTER = 16, PH_SLOTS = 17, PH_MOE1 = 18, PH_MOE2 = 19, PH_COMBINE = 20, PH_N = 21 };
__global__ void __launch_bounds__(NWAVES * 64, 2) mk_fwd(Args a) {
    extern __shared__ __attribute__((aligned(16))) unsigned char lds_raw[];
    LAS unsigned char* lds = (LAS unsigned char*)lds_raw;
    volatile LAS unsigned* MISC = (volatile LAS unsigned*)(lds + MISC_OFF);
    const int wave = __builtin_amdgcn_readfirstlane(threadIdx.x >> 6);
    for (int u = threadIdx.x; u < (LDS_BYTES - MISC_OFF) / 4; u += NWAVES * 64) ((LAS unsigned*)(lds + MISC_OFF))[u] = 0u;
    __syncthreads();
    unsigned char* ws = a.ws;
    XcdBarrier bar = xcd_barrier_post((unsigned*)(ws + WS_CTL) + CW_BAR, MISC + 8);
    const unsigned long long mask = a.mask;
#define RUN(k) ((mask >> (k)) & 1ull)
#define SEAM(k) do { if (mask >> ((k) + 1)) xcd_barrier(bar, wave); } while (0)

    if (RUN(PH_PRO)) { phase_prologue(a, lds, wave); SEAM(PH_PRO); }

    if (RUN(PH_INPROJ)) {
        GridOrder S = grid_order(T, INW, 0, ws + WS_XB, D * 2, ws + WS_WIN, D * 2);
        EpiInproj E{(bf16*)(ws + WS_QR), (bf16*)(ws + WS_KR), (bf16*)(ws + WS_VR), (bf16*)(ws + WS_AS), (bf16*)(ws + WS_GA), (bf16*)(ws + WS_GS), (const float*)(ws + WS_CS)};
        pg8::gemm_phase<EpiInproj, GridOrder>(lds, pg8::Gemm{D * 2, D * 2, D}, S, E, wave);
    }
    if (RUN(PH_KV)) {
        { GridOrder S = grid_order(BATCH * NMEM, D, 128, ws + WS_MEMB, D * 2, ws + WS_WK, D * 2);
          EpiBf16N8 E{(bf16*)(ws + WS_KC), D, 1.0f}; pg8::gemm_phase<EpiBf16N8, GridOrder>(lds, pg8::Gemm{D * 2, D * 2, D}, S, E, wave); }
        { GridOrder S = grid_order(D, BATCH * NMEM, 64, ws + WS_WV, D * 2, ws + WS_MEMB, D * 2);
          EpiBf16N8 E{(bf16*)(ws + WS_VCT), BATCH * NMEM, 1.0f}; pg8::gemm_phase<EpiBf16N8, GridOrder>(lds, pg8::Gemm{D * 2, D * 2, D}, S, E, wave); }
    }
    if (RUN(PH_INPROJ) || RUN(PH_KV)) SEAM(PH_KV);
    if (RUN(PH_ATTN)) phase_attn(a, lds, wave, (const bf16*)(ws + WS_QR), (const bf16*)(ws + WS_KR), (const bf16*)(ws + WS_VR), (bf16*)(ws + WS_AO));
    if (RUN(PH_SSMA)) {
        SsmOrder S{(int)gridDim.x, (int)((blockIdx.x + 128u) % gridDim.x), 1, (const char*)(ws + WS_AS), (const char*)(ws + WS_BTST), (size_t)256 * 512 * 2, 0};
        EpiState E{(float*)(ws + WS_SST)};
        pg8::gemm_phase<EpiState, SsmOrder>(lds, pg8::Gemm{SSM_K * 2, 512 * 2, 512}, S, E, wave);
    }
    if (RUN(PH_ATTN) || RUN(PH_SSMA)) SEAM(PH_SSMA);
    if (RUN(PH_SSMB)) { phase_ssmb(wave, (const float*)(ws + WS_SST), (const float*)(ws + WS_ABARL), (bf16*)(ws + WS_AS)); SEAM(PH_SSMB); }
    if (RUN(PH_SSMC)) {
        SsmOrder S{(int)gridDim.x, (int)blockIdx.x, 2, (const char*)(ws + WS_AS), (const char*)(ws + WS_BTS), (size_t)512 * SSM_K * 2, (size_t)256 * SSM_K * 2};
        EpiSsmOut E{(const bf16*)(ws + WS_AS), a.in[13], (bf16*)(ws + WS_Z)};
        pg8::gemm_phase<EpiSsmOut, SsmOrder>(lds, pg8::Gemm{SSM_K * 2, SSM_K * 2, SSM_K}, S, E, wave);
        SEAM(PH_SSMC);
    }
    if (RUN(PH_GLU)) {
        GridOrder S = grid_order(T, 2 * D, 0, ws + WS_Z, SSMW * 2, ws + WS_WGLU, SSMW * 2);
        EpiGlu E{(const bf16*)(ws + WS_GS), (bf16*)(ws + WS_SG)};
        pg8::gemm_phase<EpiGlu, GridOrder>(lds, pg8::Gemm{SSMW * 2, SSMW * 2, SSMW}, S, E, wave);
        SEAM(PH_GLU);
    }
    if (RUN(PH_AOUT)) {
        GridOrder S = grid_order(T, D, 0, ws + WS_AO, D * 2, ws + WS_WAO, D * 2);
        EpiMixB E{(const bf16*)(ws + WS_GA), (const bf16*)(ws + WS_SG), (bf16*)(ws + WS_MIX)};
        pg8::gemm_phase<EpiMixB, GridOrder>(lds, pg8::Gemm{D * 2, D * 2, D}, S, E, wave);
        SEAM(PH_AOUT);
    }
    if (RUN(PH_WOUT)) {
        GridOrder S = grid_order(T, D, 0, ws + WS_MIX, D * 2, ws + WS_WOUT, D * 2);
        EpiResF32 E{(float*)(ws + WS_PRE1), a.in[0]}; pg8::gemm_phase<EpiResF32, GridOrder>(lds, pg8::Gemm{D * 2, D * 2, D}, S, E, wave);
        SEAM(PH_WOUT);
    }
    if (RUN(PH_LN1)) { phase_ln((const float*)(ws + WS_PRE1), a.in[17], a.in[18], (float*)(ws + WS_X1), (bf16*)(ws + WS_X1B), nullptr, wave); SEAM(PH_LN1); }
    if (RUN(PH_QC)) {
        GridOrder S = grid_order(T, D, 0, ws + WS_X1B, D * 2, ws + WS_WQ, D * 2);
        EpiBf16N8 E{(bf16*)(ws + WS_QC), D, 0.0625f}; pg8::gemm_phase<EpiBf16N8, GridOrder>(lds, pg8::Gemm{D * 2, D * 2, D}, S, E, wave);
        SEAM(PH_QC);
    }
    if (RUN(PH_S)) {
        BhOrder S{(int)gridDim.x, (int)blockIdx.x, (const char*)(ws + WS_QC), (const char*)(ws + WS_KC), (size_t)SEQ * D * 2, (size_t)256 * D * 2, (size_t)CHD * 2, (size_t)NMEM * D * 2, (size_t)CHD * 2};
        EpiSoftmax E{(bf16*)(ws + WS_PM), D, (LAS f32x2*)(lds + MISC_OFF + 4096)};
        pg8::gemm_phase<EpiSoftmax, BhOrder>(lds, pg8::Gemm{D * 2, D * 2, CHD}, S, E, wave);
        SEAM(PH_S);
    }
    if (RUN(PH_PV)) {
        BhOrder S{(int)gridDim.x, (int)blockIdx.x, (const char*)(ws + WS_PM), (const char*)(ws + WS_VCT), (size_t)SEQ * D * 2, (size_t)256 * D * 2, (size_t)NMEM * 2, (size_t)NMEM * 2, (size_t)CHD * BATCH * NMEM * 2};
        EpiBf16N8 E{(bf16*)(ws + WS_OC), D, 1.0f};
        pg8::gemm_phase<EpiBf16N8, BhOrder>(lds, pg8::Gemm{D * 2, BATCH * NMEM * 2, NMEM}, S, E, wave);
        SEAM(PH_PV);
    }
    if (RUN(PH_WOC)) {
        GridOrder S = grid_order(T, D, 0, ws + WS_OC, D * 2, ws + WS_WOC, D * 2);
        EpiResF32 E{(float*)(ws + WS_PRE2), (const float*)(ws + WS_X1)}; pg8::gemm_phase<EpiResF32, GridOrder>(lds, pg8::Gemm{D * 2, D * 2, D}, S, E, wave);
        SEAM(PH_WOC);
    }
    if (RUN(PH_LN2)) { phase_ln((const float*)(ws + WS_PRE2), a.in[23], a.in[24], (float*)(ws + WS_X2), nullptr, (unsigned char*)(ws + WS_X2B), wave); SEAM(PH_LN2); }

    if (RUN(PH_ROUTER)) { phase_router(a, lds, wave); SEAM(PH_ROUTER); }
    if (RUN(PH_SLOTS)) { phase_slots(a, wave); SEAM(PH_SLOTS); }
    if (RUN(PH_MOE1)) {
        int stl; const int ntot = expert_tiles(a, lane_id_v(), stl);
        MoeOrder S{stl, ntot, 3, (int)gridDim.x, (int)blockIdx.x, (const char*)(ws + WS_X2B), (const char*)(ws + WS_WGU), (size_t)0, (size_t)256 * D, (size_t)2 * DE * D, (const int*)(ws + WS_SLOTTOK)};
        EpiSwigluB E{(unsigned char*)(ws + WS_RB), a.in[28]};
        pg8::gemm_phase<EpiSwigluB, MoeOrder, true, true>(lds, pg8::Gemm{D, D, D / 2, 0x7b7b7b7b, 0x7f7f7f7f}, S, E, wave);
        SEAM(PH_MOE1);
    }
    if (RUN(PH_MOE2)) {
        int stl; const int ntot = expert_tiles(a, lane_id_v(), stl);
        MoeOrder S{stl, ntot, 2, (int)gridDim.x, (int)blockIdx.x, (const char*)(ws + WS_RB), (const char*)(ws + WS_WD), (size_t)256 * DE, (size_t)256 * DE, (size_t)D * DE, nullptr};
        EpiDownB E{(bf16*)(ws + WS_RA), a.in[30], (const float*)(ws + WS_SLOTGATE)};
        pg8::gemm_phase<EpiDownB, MoeOrder, false, true>(lds, pg8::Gemm{DE, DE, DE / 2, 0x7a7a7a7a, 0x7f7f7f7f}, S, E, wave);
        SEAM(PH_MOE2);
    }
    if (RUN(PH_COMBINE)) { phase_combine(a, wave); }
#undef RUN
#undef SEAM
}

extern "C" void kernel_launch(void* const* d_in, const int* in_sizes, int n_in, void* d_out, int out_size, void* d_ws, size_t ws_size, hipStream_t stream) {
    static int ready = 0;
    if (!ready) {
        if (n_in != 33 || ws_size < WS_END) { fprintf(stderr, "kernel_launch: unexpected n_in %d / ws_size %zu\n", n_in, ws_size); ready = -1; return; }
        if (hipFuncSetAttribute((const void*)mk_fwd, hipFuncAttributeMaxDynamicSharedMemorySize, LDS_BYTES) != hipSuccess) { fprintf(stderr, "hipFuncSetAttribute failed\n"); ready = -1; return; }
        ready = 1;
    }
    if (ready < 0) return;
    char* ws = (char*)d_ws;
    (void)hipMemsetAsync(ws + WS_CTL, 0, CTL_ZERO_BYTES, stream);
    Args a{};
    for (int i = 0; i < 33; ++i) a.in[i] = (const float*)d_in[i];
    a.out = (float*)d_out; a.ws = (unsigned char*)d_ws;
    a.mask = (1ull << PH_N) - 1ull;
    hipLaunchKernelGGL(mk_fwd, dim3(256), dim3(NWAVES * 64), LDS_BYTES, stream, a);
}
```

```cpp
#include <hip/hip_runtime.h>
#include <cstdio>
#include <cstdint>
#include <cmath>

constexpr int BATCH = 16, SEQ = 2048, D = 1024, T = BATCH * SEQ;
constexpr int NQH = 16, NKVH = 2, HD = 64, WINDOW = 128;
constexpr int QW = 1024, KVW = 128, SSMW = 512, SSM_G = 32, SSM_H = 16, SSM_P = 64;
constexpr int INW = QW + 2 * KVW + SSMW + 2 * D;
constexpr int O_K = QW, O_V = O_K + KVW, O_S = O_V + KVW, O_GA = O_S + SSMW, O_GS = O_GA + D;
constexpr int NMEM = 256, NCH = 4, CHD = 256;
constexpr int NE = 32, TOPK = 4, DE = 1024;
constexpr float LN_EPS = 1e-5f;
constexpr float ALPHA = 1.189207115002721f;
constexpr int NASSIGN = T * TOPK;

namespace nv {
template <class Epi>
__global__ __launch_bounds__(256) void sgemm(const float* __restrict__ A, const int* __restrict__ ridx,
                                             const float* __restrict__ B, const int* __restrict__ tile_e, size_t bstride,
                                             int lda, int ldb, int M, int N, int K, int pad_, Epi epi) {
    __shared__ float As[16][68];
    __shared__ float Bs[16][68];
    const int tid = threadIdx.x, tx = tid & 15, ty = tid >> 4;
    const int m0 = blockIdx.y * 64, n0 = blockIdx.x * 64;
    int e = 0;
    if (tile_e) { e = tile_e[blockIdx.y]; if (e < 0) return; }
    const float* Bp = B + (size_t)e * bstride;
    float acc[4][4];
#pragma unroll
    for (int i = 0; i < 4; ++i)
#pragma unroll
        for (int j = 0; j < 4; ++j) acc[i][j] = 0.f;
    const int arow = tid >> 2, akq = (tid & 3) * 4;
    long asrc = -1;
    if (m0 + arow < M) { int r = m0 + arow; if (ridx) r = ridx[r]; asrc = (long)r * lda; }
    const int brow = tid >> 4, bcol = (tid & 15) * 4;
    for (int k0 = 0; k0 < K; k0 += 16) {
        float4 a = make_float4(0.f, 0.f, 0.f, 0.f);
        if (asrc >= 0) a = *(const float4*)(A + asrc + k0 + akq);
        As[akq + 0][arow] = a.x; As[akq + 1][arow] = a.y; As[akq + 2][arow] = a.z; As[akq + 3][arow] = a.w;
        float4 b = make_float4(0.f, 0.f, 0.f, 0.f);
        if (n0 + bcol < N) b = *(const float4*)(Bp + (size_t)(k0 + brow) * ldb + n0 + bcol);
        Bs[brow][bcol + 0] = b.x; Bs[brow][bcol + 1] = b.y; Bs[brow][bcol + 2] = b.z; Bs[brow][bcol + 3] = b.w;
        __syncthreads();
#pragma unroll
        for (int kk = 0; kk < 16; ++kk) {
            float av[4], bv[4];
#pragma unroll
            for (int i = 0; i < 4; ++i) av[i] = As[kk][ty * 4 + i];
#pragma unroll
            for (int j = 0; j < 4; ++j) bv[j] = Bs[kk][tx * 4 + j];
#pragma unroll
            for (int i = 0; i < 4; ++i)
#pragma unroll
                for (int j = 0; j < 4; ++j) acc[i][j] = fmaf(av[i], bv[j], acc[i][j]);
        }
        __syncthreads();
    }
#pragma unroll
    for (int i = 0; i < 4; ++i) {
        const int r = m0 + ty * 4 + i;
        if (r < M && n0 + tx * 4 < N) epi(r, n0 + tx * 4, acc[i], e);
    }
}

struct EpiStore { float* C; int ldc; int pad_;
    __device__ void operator()(int r, int c, const float (&v)[4], int) const { *(float4*)(C + (size_t)r * ldc + c) = make_float4(v[0], v[1], v[2], v[3]); } };
struct EpiStoreScale { float* C; int ldc; float s;
    __device__ void operator()(int r, int c, const float (&v)[4], int) const { *(float4*)(C + (size_t)r * ldc + c) = make_float4(v[0] * s, v[1] * s, v[2] * s, v[3] * s); } };
__device__ __forceinline__ float sigmoidf_(float x) { return 1.f / (1.f + expf(-x)); }
struct EpiMix { float* attn_out; const float* glu_a; const float* proj;
    __device__ void operator()(int r, int c, const float (&v)[4], int) const {
#pragma unroll
        for (int j = 0; j < 4; ++j) { const size_t o = (size_t)r * D + c + j;
            const float ga = sigmoidf_(proj[(size_t)r * INW + O_GA + c + j]), gs = sigmoidf_(proj[(size_t)r * INW + O_GS + c + j]);
            attn_out[o] = ga * attn_out[o] + gs * (glu_a[o] * sigmoidf_(v[j])); } } };
struct EpiResid { float* C; const float* res;
    __device__ void operator()(int r, int c, const float (&v)[4], int) const {
#pragma unroll
        for (int j = 0; j < 4; ++j) { const size_t o = (size_t)r * D + c + j; C[o] = ALPHA * res[o] + v[j]; } } };
struct EpiBias { float* C; const float* bias; int ldc; int N;
    __device__ void operator()(int r, int c, const float (&v)[4], int) const {
#pragma unroll
        for (int j = 0; j < 4; ++j) if (c + j < N) C[(size_t)r * ldc + c + j] = v[j] + bias[c + j]; } };
struct EpiSwiglu { float* H; const float* bgu;
    __device__ void operator()(int r, int c, const float (&v)[4], int e) const {
#pragma unroll
        for (int j = 0; j < 2; ++j) {
            float g = v[2 * j] + bgu[(size_t)e * 2 * DE + c + 2 * j], l = v[2 * j + 1] + bgu[(size_t)e * 2 * DE + c + 2 * j + 1];
            g = fminf(g, 7.0f); l = fminf(fmaxf(l, -7.0f), 7.0f);
            H[(size_t)r * DE + (c >> 1) + j] = g * sigmoidf_(1.702f * g) * (l + 1.0f); } } };
struct EpiDown { float* pre3; const float* bd; const int* slot_tok; const float* slot_gate;
    __device__ void operator()(int r, int c, const float (&v)[4], int e) const {
        const float g = slot_gate[r]; if (g == 0.f) return; const int tok = slot_tok[r];
#pragma unroll
        for (int j = 0; j < 4; ++j) atomicAdd(pre3 + (size_t)tok * D + c + j, (v[j] + bd[(size_t)e * D + c + j]) * g); } };

__global__ void rope_k(float* proj, const int* pos) {
    const size_t gid = (size_t)blockIdx.x * blockDim.x + threadIdx.x;
    if (gid >= (size_t)T * 18 * 32) return;
    const int i = gid & 31; const int hh = (gid >> 5) % 18; const size_t tok = gid / (18 * 32);
    const float inv = powf(10000.0f, -(float)i / 32.0f);
    const float ang = (float)pos[tok] * inv; const float c = cosf(ang), s = sinf(ang);
    float* p = proj + tok * INW + (hh < 16 ? hh * 64 : O_K + (hh - 16) * 64);
    const float t1 = p[i], t2 = p[i + 32];
    p[i] = t1 * c - t2 * s; p[i + 32] = t2 * c + t1 * s;
}
__global__ __launch_bounds__(64) void swa_k(const float* __restrict__ proj, const float* __restrict__ sinks, float* __restrict__ out) {
    const int gid = blockIdx.x * blockDim.x + threadIdx.x;
    if (gid >= T * NQH) return;
    const int hq = gid % NQH, tok = gid / NQH, t = tok % SEQ, b = tok / SEQ, kvh = hq / 8;
    float q[64], acc[64];
    const float* qp = proj + (size_t)tok * INW + hq * 64;
#pragma unroll
    for (int d = 0; d < 64; ++d) { q[d] = qp[d] * 0.125f; acc[d] = 0.f; }
    float m = sinks[hq], l = 1.0f;
    const int k0 = t - (WINDOW - 1) < 0 ? 0 : t - (WINDOW - 1);
    for (int kp = k0; kp <= t; ++kp) {
        const float* kr = proj + (size_t)(b * SEQ + kp) * INW + O_K + kvh * 64;
        const float* vr = proj + (size_t)(b * SEQ + kp) * INW + O_V + kvh * 64;
        float s = 0.f;
#pragma unroll
        for (int d = 0; d < 64; ++d) s = fmaf(q[d], kr[d], s);
        if (s > m) { const float sc = expf(m - s); l *= sc;
#pragma unroll
            for (int d = 0; d < 64; ++d) acc[d] *= sc;
            m = s; }
        const float p = expf(s - m); l += p;
#pragma unroll
        for (int d = 0; d < 64; ++d) acc[d] = fmaf(p, vr[d], acc[d]);
    }
    const float il = 1.0f / l;
    float* op = out + (size_t)tok * QW + hq * 64;
#pragma unroll
    for (int d = 0; d < 64; ++d) op[d] = acc[d] * il;
}
__global__ void ssm_pre_k(const float* lam_re, const float* lam_im, const float* log_dt, const float* b_re, const float* b_im,
                          float* abar, float* bbar) {
    const int gp = blockIdx.x * blockDim.x + threadIdx.x; if (gp >= SSM_G * SSM_P) return;
    const int g = gp / SSM_P;
    const float lr = lam_re[gp], li = lam_im[gp], dt = expf(log_dt[g]);
    const float mag = expf(lr * dt), ar = mag * cosf(li * dt), ai = mag * sinf(li * dt);
    const float den = lr * lr + li * li;
    const float fr = ((ar - 1.0f) * lr + ai * li) / den, fi = (ai * lr - (ar - 1.0f) * li) / den;
    abar[gp * 2] = ar; abar[gp * 2 + 1] = ai;
    for (int h = 0; h < 16; ++h) { const float br = b_re[gp * 16 + h], bi = b_im[gp * 16 + h];
        bbar[(gp * 2) * 16 + h] = fr * br - fi * bi; bbar[(gp * 2 + 1) * 16 + h] = fr * bi + fi * br; }
}
__device__ __forceinline__ float gelu_tanh(float x) { return 0.5f * x * (1.0f + tanhf(0.7978845608028654f * (x + 0.044715f * x * x * x))); }
__global__ __launch_bounds__(64) void ssm_scan_k(const float* __restrict__ proj, const float* __restrict__ abar, const float* __restrict__ bbar,
                                                 const float* __restrict__ c_re, const float* __restrict__ c_im, const float* __restrict__ d_skip, float* __restrict__ z) {
    const int g = blockIdx.x % SSM_G, b = blockIdx.x / SSM_G, p = threadIdx.x, gp = g * SSM_P + p;
    const float ar = abar[gp * 2], ai = abar[gp * 2 + 1];
    float br[16], bi[16], cr[16], ci[16];
#pragma unroll
    for (int h = 0; h < 16; ++h) { br[h] = bbar[(gp * 2) * 16 + h]; bi[h] = bbar[(gp * 2 + 1) * 16 + h];
        cr[h] = c_re[(g * 16 + h) * SSM_P + p]; ci[h] = c_im[(g * 16 + h) * SSM_P + p]; }
    const float dsk = p < 16 ? d_skip[g * 16 + p] : 0.f;
    const int pu = p < 16 ? p : 0;
    float hr = 0.f, hi = 0.f;
    for (int t = 0; t < SEQ; ++t) {
        const float* up = proj + (size_t)(b * SEQ + t) * INW + O_S + g * 16;
        float u[16];
#pragma unroll
        for (int h = 0; h < 16; ++h) u[h] = up[h];
        float bur = 0.f, bui = 0.f;
#pragma unroll
        for (int h = 0; h < 16; ++h) { bur = fmaf(br[h], u[h], bur); bui = fmaf(bi[h], u[h], bui); }
        const float nr = ar * hr - ai * hi + bur, ni = ar * hi + ai * hr + bui; hr = nr; hi = ni;
        float mine = 0.f;
#pragma unroll
        for (int h = 0; h < 16; ++h) { float v = cr[h] * hr - ci[h] * hi;
#pragma unroll
            for (int o = 32; o >= 1; o >>= 1) v += __shfl_xor(v, o);
            if (p == h) mine = v; }
        const float uown = up[pu];
        if (p < 16) { const float y = mine + dsk * uown; z[(size_t)(b * SEQ + t) * SSMW + g * 16 + p] = gelu_tanh(y); }
    }
}
__global__ __launch_bounds__(256) void ln_k(const float* __restrict__ in, const float* __restrict__ g, const float* __restrict__ bta, float* __restrict__ out, int rows, int pad_) {
    const int row = blockIdx.x * 4 + (threadIdx.x >> 6), lane = threadIdx.x & 63; if (row >= rows) return;
    const float* r = in + (size_t)row * D; float v[16]; float s = 0.f;
#pragma unroll
    for (int j = 0; j < 16; ++j) { v[j] = r[lane + 64 * j]; s += v[j]; }
#pragma unroll
    for (int o = 32; o >= 1; o >>= 1) s += __shfl_xor(s, o);
    const float mean = s * (1.0f / D); float q = 0.f;
#pragma unroll
    for (int j = 0; j < 16; ++j) { v[j] -= mean; q += v[j] * v[j]; }
#pragma unroll
    for (int o = 32; o >= 1; o >>= 1) q += __shfl_xor(q, o);
    const float rstd = rsqrtf(q * (1.0f / D) + LN_EPS);
#pragma unroll
    for (int j = 0; j < 16; ++j) out[(size_t)row * D + lane + 64 * j] = v[j] * rstd * g[lane + 64 * j] + bta[lane + 64 * j];
}
__global__ __launch_bounds__(256) void xattn_k(const float* __restrict__ qc, const float* __restrict__ kc, const float* __restrict__ vc, float* __restrict__ oc) {
    const int w = blockIdx.x * 4 + (threadIdx.x >> 6), lane = threadIdx.x & 63; if (w >= T * NCH) return;
    const int h = w % NCH, tok = w / NCH, b = tok / SEQ;
    const float4 q = *(const float4*)(qc + (size_t)tok * D + h * CHD + lane * 4);
    float m = -INFINITY, l = 0.f; float4 acc = make_float4(0.f, 0.f, 0.f, 0.f);
    for (int mm = 0; mm < NMEM; ++mm) {
        const float4 k = *(const float4*)(kc + (size_t)(b * NMEM + mm) * D + h * CHD + lane * 4);
        float s = q.x * k.x + q.y * k.y + q.z * k.z + q.w * k.w;
#pragma unroll
        for (int o = 32; o >= 1; o >>= 1) s += __shfl_xor(s, o);
        if (s > m) { const float sc = expf(m - s); l *= sc; acc.x *= sc; acc.y *= sc; acc.z *= sc; acc.w *= sc; m = s; }
        const float p = expf(s - m); l += p;
        const float4 v = *(const float4*)(vc + (size_t)(b * NMEM + mm) * D + h * CHD + lane * 4);
        acc.x = fmaf(p, v.x, acc.x); acc.y = fmaf(p, v.y, acc.y); acc.z = fmaf(p, v.z, acc.z); acc.w = fmaf(p, v.w, acc.w);
    }
    const float il = 1.0f / l;
    *(float4*)(oc + (size_t)tok * D + h * CHD + lane * 4) = make_float4(acc.x * il, acc.y * il, acc.z * il, acc.w * il);
}
__global__ void topk_k(const float* __restrict__ logits, int* __restrict__ tidx, float* __restrict__ tgate, int* __restrict__ trank, int* __restrict__ cnt) {
    const int tok = blockIdx.x * blockDim.x + threadIdx.x; if (tok >= T) return;
    float lg[NE];
#pragma unroll
    for (int e = 0; e < NE; ++e) lg[e] = logits[(size_t)tok * NE + e];
    unsigned used = 0; float tv[4]; int ti[4];
#pragma unroll
    for (int k = 0; k < 4; ++k) { float best = -INFINITY; int bi = 0;
#pragma unroll
        for (int e = 0; e < NE; ++e) { const bool ok = !((used >> e) & 1u) && lg[e] > best; best = ok ? lg[e] : best; bi = ok ? e : bi; }
        used |= 1u << bi; tv[k] = best; ti[k] = bi; }
    const float mx = tv[0]; float ex[4], s = 0.f;
#pragma unroll
    for (int k = 0; k < 4; ++k) { ex[k] = expf(tv[k] - mx); s += ex[k]; }
#pragma unroll
    for (int k = 0; k < 4; ++k) { tidx[tok * 4 + k] = ti[k]; tgate[tok * 4 + k] = ex[k] / s; trank[tok * 4 + k] = atomicAdd(cnt + ti[k], 1); }
}
__global__ void offs_k(const int* __restrict__ cnt, int* __restrict__ off, int* __restrict__ tile_e, int ntiles, int pad_) {
    if (threadIdx.x != 0 || blockIdx.x != 0) return;
    int o = 0, tl = 0;
    for (int e = 0; e < NE; ++e) { off[e] = o; const int nt = (cnt[e] + 63) / 64; for (int i = 0; i < nt; ++i) tile_e[tl++] = e; o += nt * 64; }
    for (; tl < ntiles; ++tl) tile_e[tl] = -1;
}
__global__ void fill_k(const int* __restrict__ tidx, const float* __restrict__ tgate, const int* __restrict__ trank, const int* __restrict__ off,
                       int* __restrict__ slot_tok, float* __restrict__ slot_gate) {
    const int a = blockIdx.x * blockDim.x + threadIdx.x; if (a >= NASSIGN) return;
    const int slot = off[tidx[a]] + trank[a]; slot_tok[slot] = a >> 2; slot_gate[slot] = tgate[a];
}
__global__ void scale_k(const float* __restrict__ in, float* __restrict__ out, size_t n, float s, int pad_) {
    const size_t i = (size_t)blockIdx.x * blockDim.x + threadIdx.x; if (i < n) out[i] = in[i] * s;
}
}


#define GAS __attribute__((address_space(1)))
#define LAS __attribute__((address_space(3)))
typedef unsigned short bf16;
typedef unsigned v4u __attribute__((ext_vector_type(4)));
typedef unsigned v2u __attribute__((ext_vector_type(2)));
typedef float f32x4 __attribute__((ext_vector_type(4)));
typedef float f32x2 __attribute__((ext_vector_type(2)));
typedef float f32x16 __attribute__((ext_vector_type(16)));
typedef short bf16x8 __attribute__((ext_vector_type(8)));
typedef GAS unsigned gu32;
#define RLX_AGENT __ATOMIC_RELAXED, __HIP_MEMORY_SCOPE_AGENT
#define LDS_WAIT() asm volatile("s_waitcnt lgkmcnt(0)" ::: "memory")
#define VM_WAIT() asm volatile("s_waitcnt vmcnt(0)" ::: "memory")

typedef __bf16 bf16x2_t __attribute__((ext_vector_type(2)));
__device__ __forceinline__ unsigned cvt_pk_bf16(float lo, float hi) { const f32x2 v = {lo, hi}; const bf16x2_t b = __builtin_convertvector(v, bf16x2_t); return __builtin_bit_cast(unsigned, b); }
__device__ __forceinline__ float bf_lo(unsigned w) { return __uint_as_float(w << 16); }
__device__ __forceinline__ float bf_hi(unsigned w) { return __uint_as_float(w & 0xffff0000u); }
__device__ __forceinline__ float fast_sigmoid(float x) { return __builtin_amdgcn_rcpf(1.0f + __builtin_amdgcn_exp2f(-1.4426950408889634f * x)); }
__device__ __forceinline__ int lane_id_v() { int l; asm volatile("v_mbcnt_lo_u32_b32 %0, -1, 0\n\tv_mbcnt_hi_u32_b32 %0, -1, %0" : "=v"(l)); return l; }
__device__ __forceinline__ float wave_sum(float v) {
#pragma unroll
    for (int o = 1; o < 64; o <<= 1) v += __shfl_xor(v, o);
    return v;
}

typedef int v8i __attribute__((ext_vector_type(8)));
typedef int v4i __attribute__((ext_vector_type(4)));
__device__ __forceinline__ unsigned cvt4_fp8(float a, float b, float c, float d) { int w = __builtin_amdgcn_cvt_pk_fp8_f32(a, b, 0, false); w = __builtin_amdgcn_cvt_pk_fp8_f32(c, d, w, true); return (unsigned)w; }
namespace pg8 {
constexpr int BM = 256, BK = 64, HALF = 128, HTB = HALF * BK * 2  , STAGE_BYTES = 8 * HTB;
__host__ __device__ __forceinline__ int lds_byte(int r, int c) { const int st = (r >> 4) * 2 + (c >> 5), rr = r & 15, cc = c & 31, ob = rr * 64 + cc * 2; return st * 1024 + (ob ^ (((ob >> 9) & 1) << 5)); }
__host__ __device__ __forceinline__ void stage_rc(int b, int& R, int& C) { const int st = b / 1024, sb = b % 1024, swz = sb ^ (((sb >> 9) & 1) << 5); R = (st >> 1) * 16 + swz / 64; C = (st & 1) * 32 + (swz % 64) / 2; }
__host__ __device__ __forceinline__ int perm32(int rho) { const int n = rho >> 4, i = rho & 15; return 8 * (i >> 2) + 4 * n + (i & 3); }

struct Unit { const char* A; const char* B; const int* gidx; int pm, pn, aux, aux2; };
struct Gemm { int lda, ldb, K; int sw = 0x7f7f7f7f, sx = 0x7f7f7f7f; };
__host__ __device__ __forceinline__ int lds_byte_b(int r, int bc) { const int st = (r >> 4) * 2 + (bc >> 6), ob = (r & 15) * 64 + (bc & 63); return st * 1024 + (ob ^ (((ob >> 9) & 1) << 5)); }

template <class Epi, class Sched, bool GATHER = false, bool FP8 = false, bool ALIGN_EPI = true, bool SP2 = true>
__device__ __forceinline__ void gemm_phase(LAS unsigned char* lds, const Gemm g, const Sched& S, const Epi& E, int wid) {
    const int lane = lane_id_v(), tid = wid * 64 + lane, wr = wid >> 2, wc = wid & 3, fr = lane & 15, fq = lane >> 4;
    int K = g.K; asm volatile("" : "+s"(K));
    const int nt = K / BK;
    unsigned voffA[2], voffA1[2], voffB[2];
    int gR[2], gC[2];
#pragma unroll
    for (int i = 0; i < 2; ++i) { int R, C; stage_rc(tid * 16 + i * 8192, R, C);
        if constexpr (FP8) { const int b_ = tid * 16 + i * 8192, st_ = b_ >> 10, sb_ = b_ & 1023, sw_ = sb_ ^ (((sb_ >> 8) & 1) << 4);
            R = (st_ >> 1) * 16 + (sw_ >> 6); C = ((st_ & 1) * 64 + (sw_ & 63)) / 2; }
        gR[i] = R; gC[i] = C * 2;
        voffA[i] = (unsigned)(R * g.lda + C * 2); voffA1[i] = voffA[i]; voffB[i] = (unsigned)(R * g.ldb + C * 2); }
    unsigned nvA[2] = {0u, 0u}, nvA1[2] = {0u, 0u};
    const size_t kstep = (size_t)(BK * 2);
    const size_t hstepA = GATHER ? 0 : (size_t)HALF * g.lda, hstepB = (size_t)HALF * g.ldb;
    const unsigned ldsw = (unsigned)wid * 1024u;
    const int q8_ = (wr * 4) * 2048 + (fq >> 1) * 1024 + fr * 64 + 32 * (fq & 1), p8_ = (wc * 2) * 2048 + (fq >> 1) * 1024 + fr * 64 + 32 * (fq & 1), sx8_ = 16 * ((fr >> 2) & 1);
    const int aoff = FP8 ? q8_ + sx8_ : lds_byte(wr * 64 + fr, fq * 8), boff = FP8 ? p8_ + sx8_ : lds_byte(wc * 32 + fr, fq * 8);
    const int aoffH = FP8 ? q8_ + (16 - sx8_) : aoff + 1024, boffH = FP8 ? p8_ + (16 - sx8_) : boff + 1024;
    const int sw_ = g.sw, sx_ = g.sx;
#define PG8_SA(b, h) (((b) * 2 + (h)) * HTB)
#define PG8_SB(b, h) ((4 + (b) * 2 + (h)) * HTB)
#define PG8_STAGE(bufoff, gbase, voff) do { _Pragma("unroll") for (int _i = 0; _i < 2; ++_i) \
        __builtin_amdgcn_global_load_lds((const unsigned*)((const char*)(gbase) + (voff)[_i]), (LAS unsigned*)(lds + (bufoff) + ldsw + _i * 8192), 16, 0, 0); } while (0)
#define PG8_LDA(dst, b, h) do { _Pragma("unroll") for (int m = 0; m < 4; ++m) { const v4i lo_ = *(const LAS v4i*)(lds + PG8_SA(b, h) + aoff + m * 2048), hi_ = *(const LAS v4i*)(lds + PG8_SA(b, h) + aoffH + m * 2048); \
        dst[m] = __builtin_shufflevector(lo_, hi_, 0, 1, 2, 3, 4, 5, 6, 7); } } while (0)
#define PG8_LDB(dst, b, h) do { _Pragma("unroll") for (int n = 0; n < 2; ++n) { const v4i lo_ = *(const LAS v4i*)(lds + PG8_SB(b, h) + boff + n * 2048), hi_ = *(const LAS v4i*)(lds + PG8_SB(b, h) + boffH + n * 2048); \
        dst[n] = __builtin_shufflevector(lo_, hi_, 0, 1, 2, 3, 4, 5, 6, 7); } } while (0)
#define PG8_H0(x) __builtin_bit_cast(bf16x8, __builtin_shufflevector((x), (x), 0, 1, 2, 3))
#define PG8_H1(x) __builtin_bit_cast(bf16x8, __builtin_shufflevector((x), (x), 4, 5, 6, 7))
#define PG8_MMA(ai, bj, At, Bt) do { __builtin_amdgcn_s_setprio(1); _Pragma("unroll") for (int m = 0; m < 4; ++m) _Pragma("unroll") for (int n = 0; n < 2; ++n) { \
        if constexpr (FP8) asm volatile("v_mfma_scale_f32_16x16x128_f8f6f4 %0, %1, %2, %0, %3, %4 op_sel_hi:[0,0,0]" : "+v"(acc[ai][bj][m][n]) : "v"(Bt[n]), "v"(At[m]), "v"(sw_), "v"(sx_)); \
        else { acc[ai][bj][m][n] = __builtin_amdgcn_mfma_f32_16x16x32_bf16(PG8_H0(Bt[n]), PG8_H0(At[m]), acc[ai][bj][m][n], 0, 0, 0); \
               acc[ai][bj][m][n] = __builtin_amdgcn_mfma_f32_16x16x32_bf16(PG8_H1(Bt[n]), PG8_H1(At[m]), acc[ai][bj][m][n], 0, 0, 0); } } \
        __builtin_amdgcn_s_setprio(0); } while (0)
#define PG8_WAIT_V(n) asm volatile("s_waitcnt vmcnt(" #n ")" ::: "memory")
#define PG8_WAIT_L(n) asm volatile("s_waitcnt lgkmcnt(" #n ")" ::: "memory")
#define PG8_BAR __builtin_amdgcn_s_barrier()
#define PG8_SCHED __builtin_amdgcn_sched_barrier(0)
    Unit cur, nxt; int ui = 0;
    if (!S.next(0, cur)) return;
    f32x4 acc[2][2][4][2];
#pragma unroll
    for (int a = 0; a < 2; ++a)
#pragma unroll
        for (int b = 0; b < 2; ++b)
#pragma unroll
            for (int m = 0; m < 4; ++m)
#pragma unroll
                for (int n = 0; n < 2; ++n) acc[a][b][m][n] = (f32x4){0.f, 0.f, 0.f, 0.f};
    v8i At[4], B0[2], B1[2];
    const char* cA = cur.A; const char* cB = cur.B;
    if constexpr (GATHER) {
#pragma unroll
        for (int i = 0; i < 2; ++i) { voffA[i] = (unsigned)(cur.gidx[gR[i]] * g.lda + gC[i]); voffA1[i] = (unsigned)(cur.gidx[HALF + gR[i]] * g.lda + gC[i]); } }
    if constexpr (SP2) {
        PG8_STAGE(PG8_SB(0, 0), cB, voffB); PG8_STAGE(PG8_SB(0, 1), cB + hstepB, voffB); PG8_STAGE(PG8_SA(0, 0), cA, voffA); PG8_STAGE(PG8_SA(0, 1), cA + hstepA, voffA1);
        if (wr == 1) PG8_BAR;
        PG8_WAIT_V(2); PG8_BAR;
        PG8_STAGE(PG8_SB(1, 0), cB + kstep, voffB); PG8_STAGE(PG8_SA(1, 0), cA + kstep, voffA); PG8_STAGE(PG8_SB(1, 1), cB + hstepB + kstep, voffB);
        PG8_WAIT_V(6); PG8_BAR;
    } else {
        PG8_STAGE(PG8_SB(0, 0), cB, voffB); PG8_STAGE(PG8_SA(0, 0), cA, voffA); PG8_STAGE(PG8_SB(0, 1), cB + hstepB, voffB); PG8_STAGE(PG8_SA(0, 1), cA + hstepA, voffA1);
        if (wr == 1) PG8_BAR;
        PG8_WAIT_V(4); PG8_BAR;
        PG8_STAGE(PG8_SB(1, 0), cB + kstep, voffB); PG8_STAGE(PG8_SA(1, 0), cA + kstep, voffA); PG8_STAGE(PG8_SB(1, 1), cB + hstepB + kstep, voffB);
        PG8_WAIT_V(6); PG8_BAR;
    }
    for (;;) {
        const bool has_next = S.next(ui + 1, nxt);
        const char* nA = has_next ? nxt.A : cA; const char* nB = has_next ? nxt.B : cB;
        if constexpr (GATHER) {
#pragma unroll
            for (int i = 0; i < 2; ++i) { nvA[i] = has_next ? (unsigned)(nxt.gidx[gR[i]] * g.lda + gC[i]) : voffA[i]; nvA1[i] = has_next ? (unsigned)(nxt.gidx[HALF + gR[i]] * g.lda + gC[i]) : voffA1[i]; } }
        for (int t = 0; t < nt; t += 2) {
            const bool last = (t == nt - 2);
            const char* a1 = cA + (size_t)(t + 1) * kstep;
            const char* a2 = last ? nA : cA + (size_t)(t + 2) * kstep; const char* b2 = last ? nB : cB + (size_t)(t + 2) * kstep;
            const char* a3 = a2 + kstep; const char* b3 = b2 + kstep;
            unsigned vA2[2], vA21[2];
#pragma unroll
            for (int i = 0; i < 2; ++i) { vA2[i] = (GATHER && last) ? nvA[i] : voffA[i]; vA21[i] = (GATHER && last) ? nvA1[i] : voffA1[i]; }
            if constexpr (SP2) {
            PG8_LDB(B0, 0, 0); PG8_LDB(B1, 0, 1); PG8_SCHED; PG8_LDA(At, 0, 0); PG8_STAGE(PG8_SA(1, 1), a1 + hstepA, voffA1);
            PG8_WAIT_V(8); PG8_WAIT_L(0); PG8_BAR; PG8_MMA(0, 0, At, B0); PG8_MMA(0, 1, At, B1); PG8_BAR; PG8_SCHED;
            PG8_LDA(At, 0, 1); PG8_STAGE(PG8_SB(0, 0), b2, voffB); PG8_STAGE(PG8_SB(0, 1), b2 + hstepB, voffB); PG8_STAGE(PG8_SA(0, 0), a2, vA2);
            PG8_WAIT_V(8); PG8_WAIT_L(0); PG8_BAR; PG8_MMA(1, 0, At, B0); PG8_MMA(1, 1, At, B1); PG8_BAR; PG8_SCHED;
            PG8_LDB(B0, 1, 0); PG8_LDB(B1, 1, 1); PG8_SCHED; PG8_LDA(At, 1, 0); PG8_STAGE(PG8_SA(0, 1), a2 + hstepA, vA21);
            PG8_WAIT_V(8); PG8_WAIT_L(0); PG8_BAR; PG8_MMA(0, 0, At, B0); PG8_MMA(0, 1, At, B1); PG8_BAR; PG8_SCHED;
            PG8_LDA(At, 1, 1); PG8_STAGE(PG8_SB(1, 0), b3, voffB); PG8_STAGE(PG8_SB(1, 1), b3 + hstepB, voffB); PG8_STAGE(PG8_SA(1, 0), a3, vA2);
            PG8_WAIT_V(8); PG8_WAIT_L(0); PG8_BAR; PG8_MMA(1, 0, At, B0); PG8_MMA(1, 1, At, B1); PG8_BAR; PG8_SCHED;
            } else {
            PG8_LDB(B0, 0, 0); PG8_SCHED; PG8_LDA(At, 0, 0); PG8_STAGE(PG8_SA(1, 1), a1 + hstepA, voffA1);
            PG8_WAIT_L(8); PG8_BAR; PG8_WAIT_L(0); PG8_MMA(0, 0, At, B0); PG8_BAR; PG8_SCHED;
            PG8_LDB(B1, 0, 1); PG8_STAGE(PG8_SB(0, 0), b2, voffB);
            PG8_BAR; PG8_WAIT_L(0); PG8_MMA(0, 1, At, B1); PG8_BAR;
            PG8_LDA(At, 0, 1); PG8_STAGE(PG8_SA(0, 0), a2, vA2);
            PG8_BAR; PG8_WAIT_L(0); PG8_MMA(1, 0, At, B0); PG8_BAR; PG8_SCHED;
            PG8_STAGE(PG8_SB(0, 1), b2 + hstepB, voffB);
            PG8_WAIT_V(6); PG8_BAR; PG8_MMA(1, 1, At, B1); PG8_BAR;
            PG8_LDB(B0, 1, 0); PG8_SCHED; PG8_LDA(At, 1, 0); PG8_STAGE(PG8_SA(0, 1), a2 + hstepA, vA21);
            PG8_WAIT_L(8); PG8_BAR; PG8_WAIT_L(0); PG8_MMA(0, 0, At, B0); PG8_BAR; PG8_SCHED;
            PG8_LDB(B1, 1, 1); PG8_STAGE(PG8_SB(1, 0), b3, voffB);
            PG8_BAR; PG8_WAIT_L(0); PG8_MMA(0, 1, At, B1); PG8_BAR;
            PG8_LDA(At, 1, 1); PG8_STAGE(PG8_SA(1, 0), a3, vA2);
            PG8_BAR; PG8_WAIT_L(0); PG8_MMA(1, 0, At, B0); PG8_BAR; PG8_SCHED;
            PG8_STAGE(PG8_SB(1, 1), b3 + hstepB, voffB);
            PG8_WAIT_V(6); PG8_BAR; PG8_MMA(1, 1, At, B1); PG8_BAR;
            }
        }
        if constexpr (ALIGN_EPI) { if (wr == 0) PG8_BAR; }
        if constexpr (FP8) asm volatile("s_nop 15\n\ts_nop 15" ::: "memory");
        E(acc, cur, wr, wc, fr, fq);
        if (!has_next) break;
#pragma unroll
        for (int a = 0; a < 2; ++a)
#pragma unroll
            for (int b = 0; b < 2; ++b)
#pragma unroll
                for (int m = 0; m < 4; ++m)
#pragma unroll
                    for (int n = 0; n < 2; ++n) acc[a][b][m][n] = (f32x4){0.f, 0.f, 0.f, 0.f};
        cur = nxt; cA = nA; cB = nB; ++ui;
        if constexpr (GATHER) {
#pragma unroll
            for (int i = 0; i < 2; ++i) { voffA[i] = nvA[i]; voffA1[i] = nvA1[i]; } }
        if constexpr (ALIGN_EPI) { if (wr == 1) PG8_BAR; }
    }
    PG8_WAIT_V(0);
    if constexpr (!ALIGN_EPI) { if (wr == 0) PG8_BAR; }
    PG8_BAR;
#undef PG8_SA
#undef PG8_SB
#undef PG8_STAGE
#undef PG8_LDA
#undef PG8_LDB
#undef PG8_MMA
#undef PG8_H0
#undef PG8_H1
#undef PG8_WAIT_V
#undef PG8_WAIT_L
#undef PG8_BAR
#undef PG8_SCHED
}
}

#define XB_TMO      128
#define XB_XCNT(j)  (256  + 64 * (j))
#define XB_XSUB(j)  (1280 + 64 * (j))
#define XB_XGEN(j)  (2304 + 64 * (j))
#define XB_TOP      3328
#define XB_TOPGEN   3392
#define XCD_BAR_WORDS 3456
#define XB_SPIN_CAP (1u << 18)
__device__ __forceinline__ unsigned xb_ld(unsigned* p)              { return __hip_atomic_load(p, __ATOMIC_RELAXED, __HIP_MEMORY_SCOPE_AGENT); }
__device__ __forceinline__ unsigned xb_add(unsigned* p, unsigned v) { return __hip_atomic_fetch_add(p, v, __ATOMIC_RELAXED, __HIP_MEMORY_SCOPE_AGENT); }
__device__ __forceinline__ unsigned xb_xcc_id() { return (unsigned)__builtin_amdgcn_s_getreg((3 << 11) | 20) & 0xFu; }
#define XB_SPIN(cond, bar) do { unsigned _sp = 0; while (cond) { __builtin_amdgcn_s_sleep(1); \
    if ((++_sp & 255u) == 0u) { if (xb_ld(&(bar)[XB_TMO])) break; if (_sp > XB_SPIN_CAP) { atomicAdd(&(bar)[XB_TMO], 1u); break; } } } } while (0)
struct XcdBarrier { unsigned* bar; unsigned x; volatile LAS unsigned* st; };
__device__ __forceinline__ XcdBarrier xcd_barrier_post(unsigned* bar, volatile LAS unsigned* st) {
    XcdBarrier b; b.bar = bar; b.x = xb_xcc_id(); b.st = st;
    if (threadIdx.x == 0) (void)xb_add(&bar[XB_XCNT(b.x)], 1u);
    return b;
}
__device__ __forceinline__ void xcd_barrier_complete(unsigned* bar, unsigned x, unsigned& nloc, unsigned& nx) {
    const unsigned G = gridDim.x * gridDim.y * gridDim.z;
    unsigned sum, cnt, mine, sp = 0u;
    for (;;) {
        sum = 0u; cnt = 0u; mine = 0u;
#pragma unroll
        for (unsigned j = 0; j < 16; ++j) { const unsigned c = xb_ld(&bar[XB_XCNT(j)]); sum += c; cnt += (c > 0u) ? 1u : 0u; mine = (j == x) ? c : mine; }
        if (sum == G) break;
        __builtin_amdgcn_s_sleep(1);
        if ((++sp & 255u) == 0u) { if (xb_ld(&bar[XB_TMO])) break; if (sp > XB_SPIN_CAP) { atomicAdd(&bar[XB_TMO], 1u); break; } }
    }
    nloc = mine > 0u ? mine : 1u; nx = cnt > 0u ? cnt : 1u;
}
__device__ __forceinline__ void xcd_barrier(const XcdBarrier& b, int wave) {
    asm volatile("s_waitcnt vmcnt(0)" ::: "memory");
    __syncthreads();
    if (wave == 0 && lane_id_v() == 0) {
        unsigned* bar = b.bar;
        __builtin_amdgcn_s_waitcnt(0);
        unsigned nloc = b.st[0], nx = b.st[1];
        if (nloc == 0u) { xcd_barrier_complete(bar, b.x, nloc, nx); b.st[0] = nloc; b.st[1] = nx; }
        const unsigned old = xb_add(&bar[XB_XSUB(b.x)], 1u);
        const unsigned gen = old / nloc;
        if (old + 1u == (gen + 1u) * nloc) {
            __builtin_amdgcn_fence(__ATOMIC_RELEASE, "agent");
            asm volatile("s_waitcnt vmcnt(0)" ::: "memory");
            const unsigned og = xb_add(&bar[XB_TOP], 1u);
            const unsigned tg = og / nx;
            if (og + 1u == (tg + 1u) * nx) xb_add(&bar[XB_TOPGEN], 1u);
            else XB_SPIN(xb_ld(&bar[XB_TOPGEN]) == tg, bar);
            __builtin_amdgcn_fence(__ATOMIC_ACQUIRE, "agent");
            xb_add(&bar[XB_XGEN(b.x)], 1u);
            asm volatile("s_waitcnt vmcnt(0)" ::: "memory");
        } else {
            XB_SPIN(xb_ld(&bar[XB_XGEN(b.x)]) == gen, bar);
            __builtin_amdgcn_fence(__ATOMIC_ACQUIRE, "agent");
            asm volatile("s_waitcnt vmcnt(0)" ::: "memory");
        }
    }
    __syncthreads();
}

constexpr size_t MiB = 1u << 20;
constexpr size_t WS_CTL = 0, CTL_ZERO_BYTES = 1 * MiB;
constexpr int CW_TMO = 0, CW_BAR = 4096, CW_CNT = 16384;
constexpr size_t WS_TIDX = 1 * MiB, WS_TGATE = 2 * MiB, WS_TRANK = 3 * MiB, WS_TOKSLOT = 4 * MiB, WS_SLOTGATE = 5 * MiB, WS_WGBASE = 6 * MiB;
constexpr size_t WS_WRF = 7 * MiB, WS_SLOTTOK = 9 * MiB;
constexpr size_t WS_WGU = 16 * MiB;
constexpr size_t WS_WD = 144 * MiB;
constexpr size_t WS_WMISC = 208 * MiB;
constexpr size_t WS_RA = 272 * MiB, WS_RB = 544 * MiB, WS_RC = 816 * MiB, WS_RD = 944 * MiB, WS_END = 1024 * MiB;
constexpr size_t WS_WQ = WS_WMISC + 0 * MiB, WS_WK = WS_WMISC + 2 * MiB, WS_WV = WS_WMISC + 4 * MiB, WS_WOC = WS_WMISC + 6 * MiB;
constexpr size_t WS_X1 = WS_RA, WS_X1B = WS_RA + 128 * MiB, WS_QC = WS_RA + 192 * MiB;
constexpr size_t WS_PRE1 = WS_RB, WS_PM = WS_RB, WS_OC = WS_RB + 64 * MiB, WS_PRE2 = WS_RB + 128 * MiB;
constexpr size_t WS_X2 = WS_RC, WS_X2B = WS_RD;
constexpr size_t WS_MEMB = WS_RD, WS_KC = WS_RD + 8 * MiB, WS_VCT = WS_RD + 16 * MiB;
constexpr size_t WS_WIN = WS_WMISC + 8 * MiB, WS_WAO = WS_WMISC + 16 * MiB, WS_WGLU = WS_WMISC + 18 * MiB, WS_WOUT = WS_WMISC + 20 * MiB,
                 WS_BTS = WS_WMISC + 22 * MiB  , WS_BTST = WS_WMISC + 42 * MiB  , WS_ABARL = WS_WMISC + 50 * MiB;
constexpr size_t WS_XB = WS_RA, WS_QR = WS_RA + 64 * MiB, WS_XQ = WS_RA + 128 * MiB  , WS_MIX = WS_RA + 192 * MiB;
constexpr size_t WS_WINQ = WS_WMISC + 52 * MiB;
constexpr size_t WS_GA = WS_RB, WS_GS = WS_RB + 64 * MiB, WS_AO = WS_RB + 128 * MiB, WS_SG = WS_RB + 192 * MiB, WS_SST = WS_RB + 256 * MiB;
constexpr size_t WS_AS = WS_RC, WS_Z = WS_RC + 40 * MiB, WS_KR = WS_RC + 72 * MiB, WS_VR = WS_RC + 80 * MiB, WS_CS = WS_RC + 88 * MiB;
constexpr int MAXTILE256 = (NASSIGN + NE * 255) / 256 + 1;

constexpr int RING_BYTES = 131072, MISC_OFF = RING_BYTES, LDS_BYTES = 147456;
constexpr int NWAVES = 8;

struct Args {
    const float* in[33]; float* out; unsigned char* ws;
    unsigned long long mask;
};

__host__ __device__ __forceinline__ int sigma32(int q) { return 16 * ((q >> 2) & 1) + 4 * (q >> 3) + (q & 3); }
template <class PermFn, bool KSIG = false>
__device__ __forceinline__ void transpose_item(const float* W, int K, int N, bf16* WT, LAS float* scr, int item, int lane, const PermFn& perm, int ldw = 0) {
    if (ldw == 0) ldw = N;
    const int nblk = N / 32, kb = item / nblk, nb = item % nblk, k0 = 64 * kb, n0 = 32 * nb;
#pragma unroll 8
    for (int i = 0; i < 32; ++i) { const int kk = 2 * i + (lane >> 5); const int ks = KSIG ? ((kk & 32) + sigma32(kk & 31)) : kk;
        scr[kk * 33 + (lane & 31)] = W[(size_t)(k0 + ks) * ldw + n0 + (lane & 31)]; }
    LDS_WAIT(); asm volatile("" ::: "memory");
    const int c = lane & 7;
#pragma unroll
    for (int j = 0; j < 4; ++j) { const int n = (lane >> 3) + 8 * j; const LAS float* s = scr + (8 * c) * 33 + n;
        v4u o; o.x = cvt_pk_bf16(s[0 * 33], s[1 * 33]); o.y = cvt_pk_bf16(s[2 * 33], s[3 * 33]); o.z = cvt_pk_bf16(s[4 * 33], s[5 * 33]); o.w = cvt_pk_bf16(s[6 * 33], s[7 * 33]);
        *(GAS v4u*)(WT + (size_t)perm(n0 + n) * K + k0 + 8 * c) = o; }
    LDS_WAIT(); asm volatile("" ::: "memory");
}
template <class PermFn>
__device__ __forceinline__ void transpose_item_q(const float* W, int K, int N, unsigned char* WT, LAS float* scr, int item, int lane, const PermFn& perm, float scale, int ldw = 0) {
    if (ldw == 0) ldw = N;
    const int nblk = N / 32, kb = item / nblk, nb = item % nblk, k0 = 64 * kb, n0 = 32 * nb;
    {   const int r_ = lane >> 3, q_ = lane & 7;
#pragma unroll 8
        for (int i = 0; i < 8; ++i) { const f32x4 t_ = *(const f32x4*)(W + (size_t)(k0 + 8 * i + r_) * ldw + n0 + 4 * q_);
            LAS float* d_ = scr + (8 * i + r_) * 33 + 4 * q_; d_[0] = t_[0] * scale; d_[1] = t_[1] * scale; d_[2] = t_[2] * scale; d_[3] = t_[3] * scale; }
    }
    LDS_WAIT(); asm volatile("" ::: "memory");
    const int c = lane & 3;
#pragma unroll
    for (int j = 0; j < 2; ++j) { const int n = (lane >> 2) + 16 * j; const LAS float* s = scr + (16 * c) * 33 + n;
        v4u o; o.x = cvt4_fp8(s[0 * 33], s[1 * 33], s[2 * 33], s[3 * 33]); o.y = cvt4_fp8(s[4 * 33], s[5 * 33], s[6 * 33], s[7 * 33]);
        o.z = cvt4_fp8(s[8 * 33], s[9 * 33], s[10 * 33], s[11 * 33]); o.w = cvt4_fp8(s[12 * 33], s[13 * 33], s[14 * 33], s[15 * 33]);
        *(GAS v4u*)(WT + (size_t)perm(n0 + n) * K + k0 + 16 * c) = o; }
    LDS_WAIT(); asm volatile("" ::: "memory");
}
struct PermId { __device__ __forceinline__ int operator()(int n) const { return n; } };
struct PermGU { __device__ __forceinline__ int operator()(int n) const { const int ty = n & 1, lc = n >> 1, pn = lc >> 7, wc = (lc >> 5) & 3, fq = (lc >> 3) & 3, bj = (lc >> 2) & 1, j = lc & 3;
    return 256 * pn + 128 * bj + 32 * wc + 16 * ty + 4 * fq + j; } };

__device__ __forceinline__ int crow32(int r, int hi) { return (r & 3) + 8 * (r >> 2) + 4 * hi; }
__device__ __forceinline__ void phase_router(const Args& a, LAS unsigned char* lds, int wave) {
    unsigned char* ws = a.ws; const int lane = lane_id_v(), tid = wave * 64 + lane;
    LAS int* hist = (LAS int*)(lds + 65536);
    LAS float* tile = (LAS float*)(lds + wave * 8192);
    if (tid < 32) hist[tid] = 0;
    for (int i = blockIdx.x * 512 + tid; i < MAXTILE256 * 256; i += gridDim.x * 512) ((int*)(ws + WS_SLOTTOK))[i] = 0;
    __syncthreads();
    if (wave < 4) {
        const int tok0 = (blockIdx.x * 4 + wave) * 32, r32 = lane & 31, hi = lane >> 5;
        const float* xr = (const float*)(ws + WS_X2) + (size_t)(tok0 + r32) * D + hi * 8;
        const bf16x8* wh = (const bf16x8*)(ws + WS_WRF) + hi * 32 + r32;
        const bf16x8* wl = (const bf16x8*)(ws + WS_WRF + 65536) + hi * 32 + r32;
        f32x16 acc;
#pragma unroll
        for (int r = 0; r < 16; ++r) acc[r] = 0.f;
#pragma unroll 2
        for (int s = 0; s < 64; ++s) {
            const f32x4 v0 = *(const f32x4*)(xr + s * 16), v1 = *(const f32x4*)(xr + s * 16 + 4);
            v4u h, l;
            h.x = cvt_pk_bf16(v0[0], v0[1]); h.y = cvt_pk_bf16(v0[2], v0[3]); h.z = cvt_pk_bf16(v1[0], v1[1]); h.w = cvt_pk_bf16(v1[2], v1[3]);
            l.x = cvt_pk_bf16(v0[0] - bf_lo(h.x), v0[1] - bf_hi(h.x)); l.y = cvt_pk_bf16(v0[2] - bf_lo(h.y), v0[3] - bf_hi(h.y));
            l.z = cvt_pk_bf16(v1[0] - bf_lo(h.z), v1[1] - bf_hi(h.z)); l.w = cvt_pk_bf16(v1[2] - bf_lo(h.w), v1[3] - bf_hi(h.w));
            const bf16x8 ah = __builtin_bit_cast(bf16x8, h), al = __builtin_bit_cast(bf16x8, l);
            const bf16x8 bh = wh[s * 64], bl = wl[s * 64];
            acc = __builtin_amdgcn_mfma_f32_32x32x16_bf16(ah, bh, acc, 0, 0, 0);
            acc = __builtin_amdgcn_mfma_f32_32x32x16_bf16(ah, bl, acc, 0, 0, 0);
            acc = __builtin_amdgcn_mfma_f32_32x32x16_bf16(al, bh, acc, 0, 0, 0);
        }
        const float bias = a.in[26][r32];
#pragma unroll
        for (int r = 0; r < 16; ++r) tile[crow32(r, hi) * 33 + r32] = acc[r] + bias;
        LDS_WAIT(); asm volatile("" ::: "memory");
        if (lane < 32) {
            float lg[NE];
#pragma unroll
            for (int e = 0; e < NE; ++e) lg[e] = tile[lane * 33 + e];
            unsigned used = 0; float tv[4]; int ti[4];
#pragma unroll
            for (int k = 0; k < 4; ++k) { float best = -INFINITY; int bi = 0;
#pragma unroll
                for (int e = 0; e < NE; ++e) { const bool ok = !((used >> e) & 1u) && lg[e] > best; best = ok ? lg[e] : best; bi = ok ? e : bi; }
                used |= 1u << bi; tv[k] = best; ti[k] = bi; }
            float ex[4], s = 0.f;
#pragma unroll
            for (int k = 0; k < 4; ++k) { ex[k] = __expf(tv[k] - tv[0]); s += ex[k]; }
            const float is = 1.0f / s; int rk[4];
#pragma unroll
            for (int k = 0; k < 4; ++k) rk[k] = __hip_atomic_fetch_add(hist + ti[k], 1, __ATOMIC_RELAXED, __HIP_MEMORY_SCOPE_WORKGROUP);
            const int tok = tok0 + lane;
            *(int4*)(ws + WS_TIDX + (size_t)tok * 16) = make_int4(ti[0], ti[1], ti[2], ti[3]);
            *(float4*)(ws + WS_TGATE + (size_t)tok * 16) = make_float4(ex[0] * is, ex[1] * is, ex[2] * is, ex[3] * is);
            *(int4*)(ws + WS_TRANK + (size_t)tok * 16) = make_int4(rk[0], rk[1], rk[2], rk[3]);
        }
    }
    __syncthreads();
    if (tid < 32) { const int base = (int)__hip_atomic_fetch_add((unsigned*)(ws + WS_CTL) + CW_CNT + tid, (unsigned)hist[tid], RLX_AGENT);
        ((int*)(ws + WS_WGBASE))[blockIdx.x * 32 + tid] = base; }
}

__device__ __forceinline__ int expert_tiles(const Args& a, int lane, int& start_tile) {
    const int c = lane < 32 ? (int)__hip_atomic_load((unsigned*)(a.ws + WS_CTL) + CW_CNT + lane, RLX_AGENT) : 0;
    const int tiles = (c + 255) >> 8; int incl = tiles;
#pragma unroll
    for (int o = 1; o < 64; o <<= 1) { const int t = __shfl_up(incl, o); if (lane >= o) incl += t; }
    start_tile = incl - tiles;
    return __shfl(incl, 63);
}

__device__ __forceinline__ void phase_slots(const Args& a, int wave) {
    unsigned char* ws = a.ws; const int lane = lane_id_v(), tid = wave * 64 + lane;
    int start_tile; (void)expert_tiles(a, lane, start_tile);
    const int p = blockIdx.x * 512 + tid;
    const int e = ((const int*)(ws + WS_TIDX))[p], rank = ((const int*)(ws + WS_TRANK))[p]; const float gate = ((const float*)(ws + WS_TGATE))[p];
    const int st = __shfl(start_tile, e) * 256, base = ((const int*)(ws + WS_WGBASE))[blockIdx.x * 32 + e];
    const int slot = st + base + rank;
    ((int*)(ws + WS_TOKSLOT))[p] = slot; ((float*)(ws + WS_SLOTGATE))[slot] = gate;
    ((int*)(ws + WS_SLOTTOK))[slot] = p >> 2;
}

struct MoeOrder {
    int stl, ntot, sh, G, c; const char* A; const char* B; size_t a_tile, b_tile, b_exp; const int* gbase;
    __device__ __forceinline__ bool next(int i, pg8::Unit& u) const {
        const int x = c & 7, j = c >> 3, rpx = 32 >> sh;
        const int rt = (i * 8 + x) * rpx + (j >> sh), pn = j & ((1 << sh) - 1);
        if (rt >= ntot) return false;
        const int e = __popcll(__ballot(stl <= rt)) - 1;
        u.A = A + (size_t)rt * a_tile; u.B = B + (size_t)e * b_exp + (size_t)pn * b_tile; u.gidx = gbase ? gbase + rt * 256 : nullptr; u.pm = rt; u.pn = pn; u.aux = e; u.aux2 = 0; return true;
    }
};
struct EpiSwigluB {
    unsigned char* H; const float* bgu;
    __device__ __forceinline__ void operator()(const f32x4 (&acc)[2][2][4][2], const pg8::Unit& u, int wr, int wc, int fr, int fq) const {
        const int row0 = u.pm * 256 + wr * 64 + fr, lc0 = u.pn * 128 + wc * 32 + fq * 8;
        const float* bp = bgu + (size_t)u.aux * (2 * DE) + 2 * lc0;
        f32x4 b4[4];
#pragma unroll
        for (int i = 0; i < 4; ++i) b4[i] = *(const f32x4*)(bp + 4 * i);
#pragma unroll
        for (int ai = 0; ai < 2; ++ai)
#pragma unroll
            for (int m = 0; m < 4; ++m) {
                float hv[8];
#pragma unroll
                for (int bj = 0; bj < 2; ++bj)
#pragma unroll
                    for (int j = 0; j < 4; ++j) {
                        float g = acc[ai][bj][m][0][j] + b4[2 * bj + (j >> 1)][2 * (j & 1)], l = acc[ai][bj][m][1][j] + b4[2 * bj + (j >> 1)][2 * (j & 1) + 1];
                        g = fminf(g, 7.0f); l = fminf(fmaxf(l, -7.0f), 7.0f);
                        hv[4 * bj + j] = g * fast_sigmoid(1.702f * g) * (l + 1.0f); }
                v2u o; o.x = cvt4_fp8(hv[0], hv[1], hv[2], hv[3]); o.y = cvt4_fp8(hv[4], hv[5], hv[6], hv[7]);
                *(GAS v2u*)(H + (size_t)(row0 + ai * 128 + m * 16) * DE + lc0) = o; }
    }
};
struct EpiDownB {
    bf16* Y; const float* bd; const float* slot_gate;
    __device__ __forceinline__ void operator()(const f32x4 (&acc)[2][2][4][2], const pg8::Unit& u, int wr, int wc, int fr, int fq) const {
        const int row0 = u.pm * 256 + wr * 64 + fr, col0 = u.pn * 256 + wc * 32 + fq * 4;
        f32x4 bv[2][2];
#pragma unroll
        for (int bj = 0; bj < 2; ++bj)
#pragma unroll
            for (int n = 0; n < 2; ++n) bv[bj][n] = *(const f32x4*)(bd + (size_t)u.aux * D + col0 + bj * 128 + n * 16);
#pragma unroll
        for (int ai = 0; ai < 2; ++ai)
#pragma unroll
            for (int m = 0; m < 4; ++m) { const int row = row0 + ai * 128 + m * 16; const float gt = slot_gate[row];
#pragma unroll
                for (int bj = 0; bj < 2; ++bj)
#pragma unroll
                    for (int n = 0; n < 2; ++n) { const f32x4 v = (acc[ai][bj][m][n] + bv[bj][n]) * gt;
                        v2u o; o.x = cvt_pk_bf16(v[0], v[1]); o.y = cvt_pk_bf16(v[2], v[3]);
                        *(GAS v2u*)(Y + (size_t)row * D + col0 + bj * 128 + n * 16) = o; } }
    }
};

__device__ __forceinline__ void phase_combine(const Args& a, int wave) {
    unsigned char* ws = a.ws; const int lane = lane_id_v(); const bf16* Y = (const bf16*)(ws + WS_RA);
    const float* g3 = a.in[31]; const float* b3 = a.in[32];
    const int stride = gridDim.x * NWAVES;
    for (int tok0 = blockIdx.x * NWAVES + wave; tok0 < T; tok0 += 2 * stride) {
        f32x4 v[2][4]; v2u yw[2][4][4]; float s[2] = {0.f, 0.f};
#pragma unroll
        for (int u = 0; u < 2; ++u) { const int tok = tok0 + u * stride;
            const int myslot = ((const int*)(ws + WS_TOKSLOT))[tok * 4 + (lane & 3)];
            int sl[4];
#pragma unroll
            for (int k = 0; k < 4; ++k) sl[k] = __shfl(myslot, k);
#pragma unroll
            for (int j = 0; j < 4; ++j) { v[u][j] = *(const f32x4*)((const float*)(ws + WS_X2) + (size_t)tok * D + 4 * (64 * j + lane));
#pragma unroll
                for (int k = 0; k < 4; ++k) yw[u][j][k] = *(const GAS v2u*)(Y + (size_t)sl[k] * D + 4 * (64 * j + lane)); } }
#pragma unroll
        for (int u = 0; u < 2; ++u)
#pragma unroll
            for (int j = 0; j < 4; ++j) { v[u][j] = v[u][j] * ALPHA;
#pragma unroll
                for (int k = 0; k < 4; ++k) { const v2u w = yw[u][j][k]; v[u][j][0] += bf_lo(w.x); v[u][j][1] += bf_hi(w.x); v[u][j][2] += bf_lo(w.y); v[u][j][3] += bf_hi(w.y); }
                s[u] += (v[u][j][0] + v[u][j][1]) + (v[u][j][2] + v[u][j][3]); }
        const float mean0 = wave_sum(s[0]) * (1.0f / D), mean1 = wave_sum(s[1]) * (1.0f / D); float q[2] = {0.f, 0.f};
#pragma unroll
        for (int u = 0; u < 2; ++u) { const float mean = u ? mean1 : mean0;
#pragma unroll
            for (int j = 0; j < 4; ++j) { v[u][j] = v[u][j] - mean; q[u] += (v[u][j][0] * v[u][j][0] + v[u][j][1] * v[u][j][1]) + (v[u][j][2] * v[u][j][2] + v[u][j][3] * v[u][j][3]); } }
        const float rstd0 = rsqrtf(wave_sum(q[0]) * (1.0f / D) + LN_EPS), rstd1 = rsqrtf(wave_sum(q[1]) * (1.0f / D) + LN_EPS);
#pragma unroll
        for (int j = 0; j < 4; ++j) { const int c = 4 * (64 * j + lane); const f32x4 gg = *(const f32x4*)(g3 + c), bb = *(const f32x4*)(b3 + c);
#pragma unroll
            for (int u = 0; u < 2; ++u) *(f32x4*)(a.out + (size_t)(tok0 + u * stride) * D + c) = v[u][j] * (u ? rstd1 : rstd0) * gg + bb; }
    }
}


struct GridOrder {
    int nM, nN, nwg, G, c; const char* A; const char* B; size_t a_tile, b_tile;
    __device__ __forceinline__ bool next(int i, pg8::Unit& u) const {
        const int L = i * G + c; if (L >= nwg) return false;
        int wgid = L; { const int q = nwg / 8, r = nwg % 8, xcd = wgid % 8, off = wgid / 8; wgid = (xcd < r ? xcd * (q + 1) : r * (q + 1) + (xcd - r) * q) + off; }
        const int nig = 8 * nN, gid = wgid / nig, fm = gid * 8, gsz = (nM - fm) < 8 ? (nM - fm) : 8;
        const int pm = fm + ((wgid % nig) % gsz), pn = (wgid % nig) / gsz;
        u.A = A + (size_t)pm * a_tile; u.B = B + (size_t)pn * b_tile; u.gidx = nullptr; u.pm = pm; u.pn = pn; u.aux = 0; u.aux2 = 0; return true;
    }
};
__device__ __forceinline__ GridOrder grid_order(int M, int N, int rot, const void* A, size_t lda_b, const void* B, size_t ldb_b) {
    GridOrder S; S.nM = M / 256; S.nN = N / 256; S.nwg = S.nM * S.nN; S.G = (int)gridDim.x; S.c = (int)((blockIdx.x + (unsigned)rot) % gridDim.x);
    S.A = (const char*)A; S.B = (const char*)B; S.a_tile = 256 * lda_b; S.b_tile = 256 * ldb_b; return S;
}
struct BhOrder {
    int G, c; const char* A; const char* B; size_t a_b, a_rt, a_h, b_b, b_h;
    __device__ __forceinline__ bool next(int i, pg8::Unit& u) const {
        const int L = i * G + c; if (L >= BATCH * NCH * (SEQ / 256)) return false;
        const int b = L >> 5, h = (L >> 3) & 3, rt = L & 7;
        u.A = A + (size_t)b * a_b + (size_t)rt * a_rt + (size_t)h * a_h; u.B = B + (size_t)b * b_b + (size_t)h * b_h; u.gidx = nullptr; u.pm = b * 8 + rt; u.pn = h; u.aux = 0; u.aux2 = 0; return true;
    }
};
struct EpiBf16N8 {
    bf16* O; int ldo; float scale;
    __device__ __forceinline__ void operator()(const f32x4 (&acc)[2][2][4][2], const pg8::Unit& u, int wr, int wc, int fr, int fq) const {
        const int row0 = u.pm * 256 + wr * 64 + fr, col0 = u.pn * 256 + wc * 32 + fq * 8;
#pragma unroll
        for (int ai = 0; ai < 2; ++ai)
#pragma unroll
            for (int m = 0; m < 4; ++m) { bf16* rowp = O + (size_t)(row0 + ai * 128 + m * 16) * ldo + col0;
#pragma unroll
                for (int bj = 0; bj < 2; ++bj) { const f32x4 v0 = acc[ai][bj][m][0] * scale, v1 = acc[ai][bj][m][1] * scale;
                    v4u w; w.x = cvt_pk_bf16(v0[0], v0[1]); w.y = cvt_pk_bf16(v0[2], v0[3]); w.z = cvt_pk_bf16(v1[0], v1[1]); w.w = cvt_pk_bf16(v1[2], v1[3]);
                    *(GAS v4u*)(rowp + bj * 128) = w; } }
    }
};
struct EpiResF32 {
    bf16* C; const float* res;
    __device__ __forceinline__ void operator()(const f32x4 (&acc)[2][2][4][2], const pg8::Unit& u, int wr, int wc, int fr, int fq) const {
        const int row0 = u.pm * 256 + wr * 64 + fr, col0 = u.pn * 256 + wc * 32 + fq * 4;
#pragma unroll
        for (int ai = 0; ai < 2; ++ai)
#pragma unroll
            for (int m = 0; m < 4; ++m) { const size_t ro = (size_t)(row0 + ai * 128 + m * 16) * D + col0;
#pragma unroll
                for (int bj = 0; bj < 2; ++bj)
#pragma unroll
                    for (int n = 0; n < 2; ++n) { const size_t o = ro + bj * 128 + n * 16; const f32x4 r = *(const f32x4*)(res + o);
                        const f32x4 v = r * ALPHA + acc[ai][bj][m][n]; v2u w; w.x = cvt_pk_bf16(v[0], v[1]); w.y = cvt_pk_bf16(v[2], v[3]); *(GAS v2u*)(C + o) = w; } }
    }
};
struct EpiResB16 {
    bf16* C; const bf16* res;
    __device__ __forceinline__ void operator()(const f32x4 (&acc)[2][2][4][2], const pg8::Unit& u, int wr, int wc, int fr, int fq) const {
        const int row0 = u.pm * 256 + wr * 64 + fr, col0 = u.pn * 256 + wc * 32 + fq * 4;
#pragma unroll
        for (int ai = 0; ai < 2; ++ai)
#pragma unroll
            for (int m = 0; m < 4; ++m) { const size_t ro = (size_t)(row0 + ai * 128 + m * 16) * D + col0;
#pragma unroll
                for (int bj = 0; bj < 2; ++bj)
#pragma unroll
                    for (int n = 0; n < 2; ++n) { const size_t o = ro + bj * 128 + n * 16; const v2u rw = *(const GAS v2u*)(res + o);
                        const f32x4 r = {bf_lo(rw.x), bf_hi(rw.x), bf_lo(rw.y), bf_hi(rw.y)};
                        const f32x4 v = r * ALPHA + acc[ai][bj][m][n]; v2u w; w.x = cvt_pk_bf16(v[0], v[1]); w.y = cvt_pk_bf16(v[2], v[3]); *(GAS v2u*)(C + o) = w; } }
    }
};
struct EpiSoftmax {
    bf16* O; int ldo; LAS f32x2* X;
    __device__ __forceinline__ void operator()(f32x4 (&acc)[2][2][4][2], const pg8::Unit& u, int wr, int wc, int fr_, int fq_) const {
        const int l_ = lane_id_v(), fr = l_ & 15, fq = l_ >> 4;
#pragma unroll
        for (int ai = 0; ai < 2; ++ai)
#pragma unroll
            for (int m = 0; m < 4; ++m) {
                float mx = -INFINITY;
#pragma unroll
                for (int bj = 0; bj < 2; ++bj)
#pragma unroll
                    for (int n = 0; n < 2; ++n)
#pragma unroll
                        for (int j = 0; j < 4; ++j) mx = fmaxf(mx, acc[ai][bj][m][n][j]);
                mx = fmaxf(mx, __shfl_xor(mx, 16)); mx = fmaxf(mx, __shfl_xor(mx, 32));
                float s = 0.f;
#pragma unroll
                for (int bj = 0; bj < 2; ++bj)
#pragma unroll
                    for (int n = 0; n < 2; ++n)
#pragma unroll
                        for (int j = 0; j < 4; ++j) { const float p = __builtin_amdgcn_exp2f((acc[ai][bj][m][n][j] - mx) * 1.4426950408889634f); acc[ai][bj][m][n][j] = p; s += p; }
                s += __shfl_xor(s, 16); s += __shfl_xor(s, 32);
                if (fq == 0) X[(ai * 128 + wr * 64 + m * 16 + fr) * 4 + wc] = (f32x2){mx, s};
                __builtin_amdgcn_sched_barrier(0);
            }
        LDS_WAIT(); __builtin_amdgcn_s_barrier(); asm volatile("" ::: "memory");
        const int row0 = u.pm * 256 + wr * 64 + fr, col0 = u.pn * 256 + wc * 32 + fq * 8;
#pragma unroll
        for (int ai = 0; ai < 2; ++ai)
#pragma unroll
            for (int m = 0; m < 4; ++m) {
                const int rl = ai * 128 + wr * 64 + m * 16 + fr;
                const f32x2 x0 = X[rl * 4 + 0], x1 = X[rl * 4 + 1], x2 = X[rl * 4 + 2], x3 = X[rl * 4 + 3];
                const float M = fmaxf(fmaxf(x0.x, x1.x), fmaxf(x2.x, x3.x));
                const float L = x0.y * __builtin_amdgcn_exp2f((x0.x - M) * 1.4426950408889634f) + x1.y * __builtin_amdgcn_exp2f((x1.x - M) * 1.4426950408889634f)
                              + x2.y * __builtin_amdgcn_exp2f((x2.x - M) * 1.4426950408889634f) + x3.y * __builtin_amdgcn_exp2f((x3.x - M) * 1.4426950408889634f);
                const float mown = wc == 0 ? x0.x : wc == 1 ? x1.x : wc == 2 ? x2.x : x3.x;
                const float sc = __builtin_amdgcn_exp2f((mown - M) * 1.4426950408889634f) / L;
                bf16* rowp = O + (size_t)(row0 + ai * 128 + m * 16) * ldo + col0;
#pragma unroll
                for (int bj = 0; bj < 2; ++bj) { const f32x4 v0 = acc[ai][bj][m][0] * sc, v1 = acc[ai][bj][m][1] * sc;
                    v4u w; w.x = cvt_pk_bf16(v0[0], v0[1]); w.y = cvt_pk_bf16(v0[2], v0[3]); w.z = cvt_pk_bf16(v1[0], v1[1]); w.w = cvt_pk_bf16(v1[2], v1[3]);
                    *(GAS v4u*)(rowp + bj * 128) = w; }
                __builtin_amdgcn_sched_barrier(0); }
        LDS_WAIT();
    }
};

template <bool BLOCKED = false>
__device__ __forceinline__ void phase_ln(const bf16* pre, const float* gam, const float* bet, float* outf, bf16* outb, unsigned char* outq, int wave) {
    const int lane = lane_id_v();
    const int stride = BLOCKED ? 1 : gridDim.x * NWAVES;
    const int rbeg = BLOCKED ? blockIdx.x * 128 + wave * 16 : blockIdx.x * NWAVES + wave, rend = BLOCKED ? rbeg + 16 : T;
    for (int row0 = rbeg; row0 < rend; row0 += 2 * stride) {
        f32x4 v[2][4]; float s[2] = {0.f, 0.f};
#pragma unroll
        for (int u = 0; u < 2; ++u) { const int row = row0 + u * stride;
#pragma unroll
            for (int j = 0; j < 4; ++j) { const v2u w = *(const GAS v2u*)(pre + (size_t)row * D + 4 * (64 * j + lane)); v[u][j] = (f32x4){bf_lo(w.x), bf_hi(w.x), bf_lo(w.y), bf_hi(w.y)}; } }
#pragma unroll
        for (int u = 0; u < 2; ++u) {
#pragma unroll
            for (int j = 0; j < 4; ++j) s[u] += (v[u][j][0] + v[u][j][1]) + (v[u][j][2] + v[u][j][3]); }
        const float mean0 = wave_sum(s[0]) * (1.0f / D), mean1 = wave_sum(s[1]) * (1.0f / D); float q[2] = {0.f, 0.f};
#pragma unroll
        for (int u = 0; u < 2; ++u) { const float mean = u ? mean1 : mean0;
#pragma unroll
            for (int j = 0; j < 4; ++j) { v[u][j] = v[u][j] - mean; q[u] += (v[u][j][0] * v[u][j][0] + v[u][j][1] * v[u][j][1]) + (v[u][j][2] * v[u][j][2] + v[u][j][3] * v[u][j][3]); } }
        const float rstd0 = rsqrtf(wave_sum(q[0]) * (1.0f / D) + LN_EPS), rstd1 = rsqrtf(wave_sum(q[1]) * (1.0f / D) + LN_EPS);
#pragma unroll
        for (int j = 0; j < 4; ++j) { const int c = 4 * (64 * j + lane); const f32x4 gg = *(const f32x4*)(gam + c), bb = *(const f32x4*)(bet + c);
#pragma unroll
            for (int u = 0; u < 2; ++u) { const int row = row0 + u * stride; const f32x4 o = v[u][j] * (u ? rstd1 : rstd0) * gg + bb;
                if (outf) *(f32x4*)(outf + (size_t)row * D + c) = o;
                if (outb) { v2u w; w.x = cvt_pk_bf16(o[0], o[1]); w.y = cvt_pk_bf16(o[2], o[3]); *(GAS v2u*)(outb + (size_t)row * D + c) = w; }
                if (outq) *(GAS unsigned*)(outq + (size_t)row * D + c) = cvt4_fp8(o[0], o[1], o[2], o[3]); } }
    }
}
__device__ __forceinline__ void cvt_rows(const float* src, bf16* dst, size_t n, int lane, int wave, unsigned char* dstq = nullptr) {
    const size_t stride = (size_t)gridDim.x * NWAVES * 64 * 8;
    for (size_t i = ((size_t)(blockIdx.x * NWAVES + wave) * 64 + lane) * 8; i < n; i += stride) {
        const f32x4 v0 = *(const f32x4*)(src + i), v1 = *(const f32x4*)(src + i + 4);
        v4u o; o.x = cvt_pk_bf16(v0[0], v0[1]); o.y = cvt_pk_bf16(v0[2], v0[3]); o.z = cvt_pk_bf16(v1[0], v1[1]); o.w = cvt_pk_bf16(v1[2], v1[3]);
        *(GAS v4u*)(dst + i) = o;
        if (dstq) { v2u q; q.x = cvt4_fp8(v0[0], v0[1], v0[2], v0[3]); q.y = cvt4_fp8(v1[0], v1[1], v1[2], v1[3]); *(GAS v2u*)(dstq + i) = q; } }
}

constexpr float LOG2E = 1.4426950408889634f;
typedef float f32x8 __attribute__((ext_vector_type(8)));
constexpr int SSM_L = 32, SSM_NCH = SEQ / SSM_L  , SSM_ROWS = BATCH * SSM_NCH  , SSM_K = SSM_L * SSM_H + 2 * SSM_P  ;

struct PermWin { __device__ __forceinline__ int operator()(int n) const { if (n >= O_V) return n; const int d = n & 63; return (n & ~63) + 2 * (d & 31) + (d >> 5); } };
template <int TY> struct PermGlu { __device__ __forceinline__ int operator()(int lc) const { const int pn = lc >> 7, wc = (lc >> 5) & 3, fq = (lc >> 3) & 3, bj = (lc >> 2) & 1, j = lc & 3;
    return 256 * pn + 128 * bj + 32 * wc + 16 * TY + 4 * fq + j; } };

__device__ __forceinline__ float gelu_tanh_f(float x) {
    const float u = 0.7978845608028654f * (x + 0.044715f * x * x * x);
    const float e = __builtin_amdgcn_exp2f(2.0f * LOG2E * u);
    return x * (1.0f - __builtin_amdgcn_rcpf(e + 1.0f));
}

struct EpiInproj {
    bf16 *QR, *KR, *VR, *AS, *GA, *GS; const float* cs; int pn0;
    __device__ __forceinline__ static void rot(f32x4& v, const f32x4 c) { const float a0 = v[0] * c[0] - v[1] * c[1], a1 = v[1] * c[0] + v[0] * c[1], a2 = v[2] * c[2] - v[3] * c[3], a3 = v[3] * c[2] + v[2] * c[3]; v = (f32x4){a0, a1, a2, a3}; }
    __device__ __forceinline__ void operator()(const f32x4 (&acc)[2][2][4][2], const pg8::Unit& u, int wr, int wc, int fr, int fq) const {
        const int pn = u.pn + pn0, row0 = u.pm * 256 + wr * 64 + fr;
        if (pn < 5) {
            const float qs = pn < 4 ? 0.125f * LOG2E : 1.0f;
#pragma unroll
            for (int ai = 0; ai < 2; ++ai)
#pragma unroll
                for (int m = 0; m < 4; ++m) { const int row = row0 + ai * 128 + m * 16;
                    const float* cp = cs + (size_t)row * 64 + 2 * (16 * (wc & 1) + 2 * fq);
#pragma unroll
                    for (int bj = 0; bj < 2; ++bj) { f32x4 v0 = acc[ai][bj][m][0], v1 = acc[ai][bj][m][1];
                        const bool isv = (pn == 4) && (bj == 1);
                        if (!isv) { const f32x4 c0 = *(const f32x4*)cp, c1 = *(const f32x4*)(cp + 16); rot(v0, c0); rot(v1, c1); v0 = v0 * qs; v1 = v1 * qs; }
                        v4u w; w.x = cvt_pk_bf16(v0[0], v0[1]); w.y = cvt_pk_bf16(v0[2], v0[3]); w.z = cvt_pk_bf16(v1[0], v1[1]); w.w = cvt_pk_bf16(v1[2], v1[3]);
                        bf16* dst = pn < 4 ? QR + (size_t)row * QW + 256 * pn + 128 * bj + 32 * wc + 8 * fq : (bj == 0 ? KR : VR) + (size_t)row * KVW + 32 * wc + 8 * fq;
                        *(GAS v4u*)dst = w; } }
        } else if (pn < 7) {
#pragma unroll
            for (int ai = 0; ai < 2; ++ai)
#pragma unroll
                for (int m = 0; m < 4; ++m) { const int row = row0 + ai * 128 + m * 16, b = row >> 11, t = row & (SEQ - 1);
                    const size_t rbase = ((size_t)(b * SSM_NCH + (t >> 5)) * SSM_K + (t & 31) * 16 + 4 * fq);
#pragma unroll
                    for (int bj = 0; bj < 2; ++bj)
#pragma unroll
                        for (int n = 0; n < 2; ++n) { const int g = 16 * (pn - 5) + 8 * bj + 2 * wc + n; const f32x4 v = acc[ai][bj][m][n];
                            v2u w; w.x = cvt_pk_bf16(v[0], v[1]); w.y = cvt_pk_bf16(v[2], v[3]);
                            *(GAS v2u*)(AS + (size_t)g * SSM_ROWS * SSM_K + rbase) = w; } }
        } else {
            bf16* base = pn < 11 ? GA : GS; const int cb = 256 * ((pn - 7) & 3);
#pragma unroll
            for (int ai = 0; ai < 2; ++ai)
#pragma unroll
                for (int m = 0; m < 4; ++m) { const int row = row0 + ai * 128 + m * 16;
#pragma unroll
                    for (int bj = 0; bj < 2; ++bj) { const f32x4 v0 = acc[ai][bj][m][0], v1 = acc[ai][bj][m][1];
                        v4u w; w.x = cvt_pk_bf16(fast_sigmoid(v0[0]), fast_sigmoid(v0[1])); w.y = cvt_pk_bf16(fast_sigmoid(v0[2]), fast_sigmoid(v0[3]));
                        w.z = cvt_pk_bf16(fast_sigmoid(v1[0]), fast_sigmoid(v1[1])); w.w = cvt_pk_bf16(fast_sigmoid(v1[2]), fast_sigmoid(v1[3]));
                        *(GAS v4u*)(base + (size_t)row * D + cb + 128 * bj + 32 * wc + 8 * fq) = w; } }
        }
    }
};

constexpr int AT_KSTR = 144, AT_VSTR = 328, AT_VOFF = 160 * AT_KSTR, AT_BUF = 45056;
__device__ __forceinline__ void phase_attn(const Args& a, LAS unsigned char* lds, int wave, const bf16* QR, const bf16* KR, const bf16* VR, bf16* AO) {
    const int lane = lane_id_v(), tid = wave * 64 + lane, r32 = lane & 31, hi = lane >> 5;
    const int nunits = BATCH * NKVH * (SEQ / 32);
    v4u kreg[3], vreg[3]; bf16x8 qnext[4];
#define AT_LOAD(L_) do { const int b_ = (L_) >> 7, kvh_ = ((L_) >> 6) & 1, q0_ = ((L_) & 63) * 32; const size_t tok0_ = (size_t)b_ * SEQ; \
        _Pragma("unroll") for (int i_ = 0; i_ < 3; ++i_) { const int c_ = tid + i_ * 512; if (c_ < 160 * 8) { const int key_ = c_ >> 3, ch_ = c_ & 7, kpos_ = q0_ - 128 + key_, kp_ = kpos_ < 0 ? 0 : kpos_; \
            kreg[i_] = *(const GAS v4u*)(KR + (tok0_ + kp_) * KVW + kvh_ * 64 + ch_ * 8); vreg[i_] = *(const GAS v4u*)(VR + (tok0_ + kp_) * KVW + kvh_ * 64 + ch_ * 8); } } \
        _Pragma("unroll") for (int s_ = 0; s_ < 4; ++s_) qnext[s_] = *(const bf16x8*)(QR + (tok0_ + q0_ + r32) * QW + (kvh_ * 8 + wave) * 64 + s_ * 16 + hi * 8); } while (0)
    int L = blockIdx.x, par = 0;
    if (L < nunits) AT_LOAD(L);
    for (; L < nunits; L += gridDim.x, par ^= 1) {
        const int b = L >> 7, kvh = (L >> 6) & 1, q0 = (L & 63) * 32;
        const size_t tok0 = (size_t)b * SEQ;
        LAS unsigned char* buf = lds + par * AT_BUF;
#pragma unroll
        for (int i = 0; i < 3; ++i) { const int c = tid + i * 512; if (c < 160 * 8) { const int key = c >> 3, ch = c & 7; const v4u vv = vreg[i];
            *(LAS v4u*)(buf + key * AT_KSTR + ch * 16) = kreg[i];
            LAS bf16* vt = (LAS bf16*)(buf + AT_VOFF + (ch * 8) * AT_VSTR + key * 2);
            vt[0 * (AT_VSTR / 2)] = (bf16)(vv.x & 0xffffu); vt[1 * (AT_VSTR / 2)] = (bf16)(vv.x >> 16);
            vt[2 * (AT_VSTR / 2)] = (bf16)(vv.y & 0xffffu); vt[3 * (AT_VSTR / 2)] = (bf16)(vv.y >> 16);
            vt[4 * (AT_VSTR / 2)] = (bf16)(vv.z & 0xffffu); vt[5 * (AT_VSTR / 2)] = (bf16)(vv.z >> 16);
            vt[6 * (AT_VSTR / 2)] = (bf16)(vv.w & 0xffffu); vt[7 * (AT_VSTR / 2)] = (bf16)(vv.w >> 16); } }
        const int hq = kvh * 8 + wave;
        bf16x8 qf[4];
#pragma unroll
        for (int s = 0; s < 4; ++s) qf[s] = qnext[s];
        if (L + (int)gridDim.x < nunits) AT_LOAD(L + (int)gridDim.x);
        __syncthreads();
        f32x16 sc[5];
#pragma unroll
        for (int kb = 0; kb < 5; ++kb) {
            f32x16 acc;
#pragma unroll
            for (int r = 0; r < 16; ++r) acc[r] = 0.f;
#pragma unroll
            for (int s = 0; s < 4; ++s) { const bf16x8 kf = *(const LAS bf16x8*)(buf + (kb * 32 + r32) * AT_KSTR + (s * 16 + hi * 8) * 2);
                acc = __builtin_amdgcn_mfma_f32_32x32x16_bf16(kf, qf[s], acc, 0, 0, 0); }
            sc[kb] = acc;
        }
        const float sink = a.in[4][hq] * LOG2E;
        float mx = sink;
        const int kmin = 128 - q0;
#pragma unroll
        for (int kb = 0; kb < 5; ++kb)
#pragma unroll
            for (int r = 0; r < 16; ++r) { const int key = kb * 32 + (r & 3) + 8 * (r >> 2) + 4 * hi;
                bool ok = key >= kmin; if (kb == 0) ok = ok && (key > r32); if (kb == 4) ok = ok && (key - 128 <= r32);
                const float s = ok ? sc[kb][r] : -INFINITY; sc[kb][r] = s; mx = fmaxf(mx, s); }
        mx = fmaxf(mx, __shfl_xor(mx, 32));
        float ls = 0.f;
#pragma unroll
        for (int kb = 0; kb < 5; ++kb)
#pragma unroll
            for (int r = 0; r < 16; ++r) { const float p = __builtin_amdgcn_exp2f(sc[kb][r] - mx); sc[kb][r] = p; ls += p; }
        ls += __shfl_xor(ls, 32);
        ls += __builtin_amdgcn_exp2f(sink - mx);
        f32x16 o[2];
#pragma unroll
        for (int r = 0; r < 16; ++r) { o[0][r] = 0.f; o[1][r] = 0.f; }
#pragma unroll
        for (int kb = 0; kb < 5; ++kb)
#pragma unroll
            for (int s2 = 0; s2 < 2; ++s2) {
                v4u pk; pk.x = cvt_pk_bf16(sc[kb][8 * s2 + 0], sc[kb][8 * s2 + 1]); pk.y = cvt_pk_bf16(sc[kb][8 * s2 + 2], sc[kb][8 * s2 + 3]);
                pk.z = cvt_pk_bf16(sc[kb][8 * s2 + 4], sc[kb][8 * s2 + 5]); pk.w = cvt_pk_bf16(sc[kb][8 * s2 + 6], sc[kb][8 * s2 + 7]);
                const bf16x8 pf = __builtin_bit_cast(bf16x8, pk);
#pragma unroll
                for (int db = 0; db < 2; ++db) { const LAS unsigned char* vp = buf + AT_VOFF + (db * 32 + r32) * AT_VSTR + (kb * 32 + 16 * s2 + 4 * hi) * 2;
                    const v2u lo = *(const LAS v2u*)vp, hh = *(const LAS v2u*)(vp + 16);
                    const v4u av = {lo.x, lo.y, hh.x, hh.y};
                    o[db] = __builtin_amdgcn_mfma_f32_32x32x16_bf16(__builtin_bit_cast(bf16x8, av), pf, o[db], 0, 0, 0); }
            }
        const float inv = 1.0f / ls;
        bf16* op = AO + (tok0 + q0 + r32) * QW + hq * 64 + 4 * hi;
#pragma unroll
        for (int db = 0; db < 2; ++db)
#pragma unroll
            for (int g4 = 0; g4 < 4; ++g4) { v2u w; w.x = cvt_pk_bf16(o[db][4 * g4] * inv, o[db][4 * g4 + 1] * inv); w.y = cvt_pk_bf16(o[db][4 * g4 + 2] * inv, o[db][4 * g4 + 3] * inv);
                *(GAS v2u*)(op + db * 32 + 8 * g4) = w; }
    }
#undef AT_LOAD
    __syncthreads();
}

__device__ __forceinline__ void ssm_precompute(const Args& a, LAS unsigned char* lds, int g, int wave, bf16* BTS, bf16* BTST, float* ABARL) {
    const int lane = lane_id_v(), tid = wave * 64 + lane;
    LAS f32x2* PW = (LAS f32x2*)lds;
    LAS f32x2* BB = (LAS f32x2*)(lds + 16896);
    LAS f32x2* CC = (LAS f32x2*)(lds + 16896 + 8192);
    LAS float* KT = (LAS float*)(lds + 16896 + 16384);
    const float dt = expf(a.in[8][g]);
    for (int i = tid; i < 33 * 64; i += 512) { const int d = i >> 6, p = i & 63; const float lr = a.in[6][g * 64 + p], li = a.in[7][g * 64 + p];
        const float mag = expf((float)d * (lr * dt)); const float ang = (float)d * (li * dt); PW[i] = (f32x2){mag * cosf(ang), mag * sinf(ang)}; }
    for (int i = tid; i < 64 * 16; i += 512) { const int p = i >> 4; const float lr = a.in[6][g * 64 + p], li = a.in[7][g * 64 + p], th = li * dt;
        const float s = sinf(th), c = cosf(th); const float em1 = expm1f(lr * dt), sh = sinf(0.5f * th);
        const float xr = em1 * c - 2.0f * sh * sh, xi = (em1 + 1.0f) * s, den = lr * lr + li * li;
        const float fr = (xr * lr + xi * li) / den, fi = (xi * lr - xr * li) / den;
        const float br = a.in[9][(size_t)(g * 64) * 16 + i], bi = a.in[10][(size_t)(g * 64) * 16 + i];
        BB[i] = (f32x2){fr * br - fi * bi, fr * bi + fi * br}; }
    for (int i = tid; i < 16 * 64; i += 512) CC[i] = (f32x2){a.in[11][(size_t)g * 1024 + i], a.in[12][(size_t)g * 1024 + i]};
    __syncthreads();
    for (int i = tid; i < 32 * 256; i += 512) { const int d = i >> 8, ho = (i >> 4) & 15, hh = i & 15; float acc = 0.f;
        for (int p = 0; p < 64; ++p) { const f32x2 c = CC[ho * 64 + p], w = PW[d * 64 + p], bb = BB[p * 16 + hh];
            const float tr = c.x * w.x - c.y * w.y, ti = c.x * w.y + c.y * w.x; acc += tr * bb.x - ti * bb.y; }
        KT[i] = acc; }
    __syncthreads();
    for (int q = tid; q < 512 * (SSM_K / 8); q += 512) { const int n = q / (SSM_K / 8), k0 = (q % (SSM_K / 8)) * 8, i = n >> 4, ho = n & 15; f32x8 v;
        if (k0 < 512) { const int d = i - (k0 >> 4), h0 = k0 & 15;
#pragma unroll
            for (int e = 0; e < 8; ++e) v[e] = d >= 0 ? KT[((d < 0 ? 0 : d) * 16 + ho) * 16 + h0 + e] : 0.f; }
        else { const bool im = k0 >= 576; const int p0 = k0 - (im ? 576 : 512);
#pragma unroll
            for (int e = 0; e < 8; ++e) { const f32x2 c = CC[ho * 64 + p0 + e], w = PW[(i + 1) * 64 + p0 + e]; v[e] = im ? -(c.x * w.y + c.y * w.x) : (c.x * w.x - c.y * w.y); } }
        v4u o; o.x = cvt_pk_bf16(v[0], v[1]); o.y = cvt_pk_bf16(v[2], v[3]); o.z = cvt_pk_bf16(v[4], v[5]); o.w = cvt_pk_bf16(v[6], v[7]);
        *(GAS v4u*)(BTS + ((size_t)(g * 512 + n) * SSM_K + k0)) = o; }
    for (int q = tid; q < 256 * 64; q += 512) { const int n = q >> 6, k0 = (q & 63) * 8, j = k0 >> 4, h0 = k0 & 15, p = n & 63; f32x8 v;
        const f32x2 w = PW[(31 - j) * 64 + p];
#pragma unroll
        for (int e = 0; e < 8; ++e) { const f32x2 bb = BB[p * 16 + h0 + e]; const float re = w.x * bb.x - w.y * bb.y, im = w.x * bb.y + w.y * bb.x; v[e] = n < 64 ? re : (n < 128 ? im : 0.f); }
        v4u o; o.x = cvt_pk_bf16(v[0], v[1]); o.y = cvt_pk_bf16(v[2], v[3]); o.z = cvt_pk_bf16(v[4], v[5]); o.w = cvt_pk_bf16(v[6], v[7]);
        *(GAS v4u*)(BTST + ((size_t)(g * 256 + n) * 512 + k0)) = o; }
    if (tid < 64) { const f32x2 w = PW[32 * 64 + tid]; ABARL[(g * 64 + tid) * 2] = w.x; ABARL[(g * 64 + tid) * 2 + 1] = w.y; }
    __syncthreads();
}

struct SsmOrder {
    int G, c, npn; const char* A; const char* B; size_t b_g, b_tile;
    __device__ __forceinline__ bool next(int i, pg8::Unit& u) const {
        const int L = i * G + c; if (L >= SSM_G * 4 * npn) return false;
        const int g = L / (4 * npn), r = L % (4 * npn), rt = r / npn, pn = r % npn;
        u.A = A + (size_t)(g * 4 + rt) * 256 * (SSM_K * 2); u.B = B + (size_t)g * b_g + (size_t)pn * b_tile; u.gidx = nullptr; u.pm = g * 4 + rt; u.pn = pn; u.aux = g; u.aux2 = 0; return true;
    }
};
struct EpiState {
    float* S;
    __device__ __forceinline__ void operator()(const f32x4 (&acc)[2][2][4][2], const pg8::Unit& u, int wr, int wc, int fr, int fq) const {
        const int row0 = u.pm * 256 + wr * 64 + fr, col0 = wc * 32 + fq * 4;
#pragma unroll
        for (int ai = 0; ai < 2; ++ai)
#pragma unroll
            for (int m = 0; m < 4; ++m)
#pragma unroll
                for (int n = 0; n < 2; ++n) *(f32x4*)(S + (size_t)(row0 + ai * 128 + m * 16) * 128 + col0 + n * 16) = acc[ai][0][m][n];
    }
};
__device__ __forceinline__ void phase_ssmb(int wave, const float* S, const float* ABARL, bf16* AS) {
    const int lane = lane_id_v(), idx = (blockIdx.x * NWAVES + wave) * 64 + lane;
    if (idx >= BATCH * SSM_G * SSM_P) return;
    const int p = idx & 63, g = (idx >> 6) & 31, b = idx >> 11;
    const float ar = ABARL[(g * 64 + p) * 2], ai = ABARL[(g * 64 + p) * 2 + 1];
    float hr = 0.f, hi = 0.f;
#pragma unroll 8
    for (int c = 0; c < SSM_NCH; ++c) { const size_t row = (size_t)g * SSM_ROWS + b * SSM_NCH + c;
        AS[row * SSM_K + 512 + p] = (bf16)(cvt_pk_bf16(hr, 0.f) & 0xffffu); AS[row * SSM_K + 576 + p] = (bf16)(cvt_pk_bf16(hi, 0.f) & 0xffffu);
        const float sr = S[row * 128 + p], si = S[row * 128 + 64 + p];
        const float nr = ar * hr - ai * hi + sr, ni = ar * hi + ai * hr + si; hr = nr; hi = ni; }
}
struct EpiSsmOut {
    const bf16* AS; const float* dsk; unsigned char* Z;
    __device__ __forceinline__ void operator()(const f32x4 (&acc)[2][2][4][2], const pg8::Unit& u, int wr, int wc, int fr, int fq) const {
        const int g = u.aux, rbase = (u.pm & 3) * 256 + wr * 64 + fr;
        const f32x4 dk = *(const f32x4*)(dsk + 16 * g + 4 * fq);
#pragma unroll
        for (int ai = 0; ai < 2; ++ai)
#pragma unroll
            for (int m = 0; m < 4; ++m) { const int rg = rbase + ai * 128 + m * 16, b = rg >> 6, ch = rg & 63;
                const bf16* arow = AS + ((size_t)g * SSM_ROWS + rg) * SSM_K + 4 * fq;
#pragma unroll
                for (int bj = 0; bj < 2; ++bj)
#pragma unroll
                    for (int n = 0; n < 2; ++n) { const int i = 16 * u.pn + 8 * bj + 2 * wc + n;
                        const v2u uw = *(const GAS v2u*)(arow + i * 16);
                        const f32x4 uu = {bf_lo(uw.x), bf_hi(uw.x), bf_lo(uw.y), bf_hi(uw.y)};
                        const f32x4 y = acc[ai][bj][m][n] + dk * uu;
                        *(GAS unsigned*)(Z + ((size_t)b * SEQ + ch * 32 + i) * SSMW + 16 * g + 4 * fq) = cvt4_fp8(gelu_tanh_f(y[0]), gelu_tanh_f(y[1]), gelu_tanh_f(y[2]), gelu_tanh_f(y[3])); } }
    }
};
struct EpiGlu {
    const bf16* GS; bf16* SG;
    __device__ __forceinline__ void operator()(const f32x4 (&acc)[2][2][4][2], const pg8::Unit& u, int wr, int wc, int fr, int fq) const {
        const int row0 = u.pm * 256 + wr * 64 + fr, pb = 128 * u.pn + 32 * wc + 16 * (fq & 1) + 4 * (fq >> 1);
#pragma unroll
        for (int ai = 0; ai < 2; ++ai)
#pragma unroll
            for (int m = 0; m < 4; ++m) { const size_t ro = (size_t)(row0 + ai * 128 + m * 16) * D + pb;
#pragma unroll
                for (int bj = 0; bj < 2; ++bj) { const v2u gw = *(const GAS v2u*)(GS + ro + 8 * bj);
                    const f32x4 gs = {bf_lo(gw.x), bf_hi(gw.x), bf_lo(gw.y), bf_hi(gw.y)}; const f32x4 av = acc[ai][bj][m][0], bv = acc[ai][bj][m][1];
                    v2u w; w.x = cvt_pk_bf16(gs[0] * av[0] * fast_sigmoid(bv[0]), gs[1] * av[1] * fast_sigmoid(bv[1]));
                    w.y = cvt_pk_bf16(gs[2] * av[2] * fast_sigmoid(bv[2]), gs[3] * av[3] * fast_sigmoid(bv[3]));
                    *(GAS v2u*)(SG + ro + 8 * bj) = w; } }
    }
};
struct EpiMixB {
    const bf16* GA; const bf16* SG; bf16* MIX;
    __device__ __forceinline__ void operator()(const f32x4 (&acc)[2][2][4][2], const pg8::Unit& u, int wr, int wc, int fr, int fq) const {
        const int row0 = u.pm * 256 + wr * 64 + fr, col0 = u.pn * 256 + wc * 32 + fq * 8;
#pragma unroll
        for (int ai = 0; ai < 2; ++ai)
#pragma unroll
            for (int m = 0; m < 4; ++m) { const size_t ro = (size_t)(row0 + ai * 128 + m * 16) * D + col0;
#pragma unroll
                for (int bj = 0; bj < 2; ++bj) { const v4u g = *(const GAS v4u*)(GA + ro + bj * 128), s = *(const GAS v4u*)(SG + ro + bj * 128);
                    const f32x4 v0 = acc[ai][bj][m][0], v1 = acc[ai][bj][m][1];
                    v4u w; w.x = cvt_pk_bf16(bf_lo(g.x) * v0[0] + bf_lo(s.x), bf_hi(g.x) * v0[1] + bf_hi(s.x)); w.y = cvt_pk_bf16(bf_lo(g.y) * v0[2] + bf_lo(s.y), bf_hi(g.y) * v0[3] + bf_hi(s.y));
                    w.z = cvt_pk_bf16(bf_lo(g.z) * v1[0] + bf_lo(s.z), bf_hi(g.z) * v1[1] + bf_hi(s.z)); w.w = cvt_pk_bf16(bf_lo(g.w) * v1[2] + bf_lo(s.w), bf_hi(g.w) * v1[3] + bf_hi(s.w));
                    *(GAS v4u*)(MIX + ro + bj * 128) = w; } }
    }
};

__device__ __forceinline__ void phase_prologue(const Args& a, LAS unsigned char* lds, int wave) {
    unsigned char* ws = a.ws; const int lane = lane_id_v();
    LAS float* scr = (LAS float*)(lds + wave * 16384);
    const int gw = blockIdx.x * NWAVES + wave, NGW = gridDim.x * NWAVES;
    constexpr int I_SQ = (D / 64) * (D / 32);
    constexpr int I_GU = (D / 64) * (2 * DE / 32), I_D = (DE / 64) * (D / 32);
    constexpr int I_IN = (D / 64) * (O_GA / 32), I_GT = (D / 64) * (2 * D / 32), I_GL = (SSMW / 64) * (D / 32);
    constexpr int N_SMALL = 6 * I_SQ + I_IN + I_GT + 2 * I_GL;
    if (blockIdx.x < SSM_G) ssm_precompute(a, lds, (int)blockIdx.x, wave, (bf16*)(ws + WS_BTS), (bf16*)(ws + WS_BTST), (float*)(ws + WS_ABARL));
    const bool ssm_wg = blockIdx.x < SSM_G;
    const int gwx = ((int)blockIdx.x - SSM_G) * NWAVES + wave, NGWX = ((int)gridDim.x - SSM_G) * NWAVES;
    for (int it = gw; it < N_SMALL; it += NGW) {
        int r = it;
        if (r < I_IN) { transpose_item(a.in[3], D, O_GA, (bf16*)(ws + WS_WIN), scr, r, lane, PermWin{}, INW); continue; } r -= I_IN;
        if (r < I_GT) { transpose_item_q(a.in[3] + O_GA, D, 2 * D, (unsigned char*)(ws + WS_WINQ), scr, r, lane, PermId{}, 16.0f, INW); continue; } r -= I_GT;
        if (r < I_SQ) { transpose_item<PermId, true>(a.in[5], D, D, (bf16*)(ws + WS_WAO), scr, r, lane, PermId{}); continue; } r -= I_SQ;
        if (r < I_GL) { transpose_item_q(a.in[14], SSMW, D, (unsigned char*)(ws + WS_WGLU), scr, r, lane, PermGlu<0>{}, 16.0f); continue; } r -= I_GL;
        if (r < I_GL) { transpose_item_q(a.in[15], SSMW, D, (unsigned char*)(ws + WS_WGLU), scr, r, lane, PermGlu<1>{}, 16.0f); continue; } r -= I_GL;
        if (r < I_SQ) { transpose_item<PermId, true>(a.in[16], D, D, (bf16*)(ws + WS_WOUT), scr, r, lane, PermId{}); continue; } r -= I_SQ;
        if (r < I_SQ) { transpose_item(a.in[19], D, D, (bf16*)(ws + WS_WQ), scr, r, lane, PermId{}); continue; } r -= I_SQ;
        if (r < I_SQ) { transpose_item(a.in[20], D, D, (bf16*)(ws + WS_WK), scr, r, lane, PermId{}); continue; } r -= I_SQ;
        if (r < I_SQ) { transpose_item(a.in[21], D, D, (bf16*)(ws + WS_WV), scr, r, lane, PermId{}); continue; } r -= I_SQ;
        if (r < I_SQ) { transpose_item<PermId, true>(a.in[22], D, D, (bf16*)(ws + WS_WOC), scr, r, lane, PermId{}); continue; } r -= I_SQ;
    }
    if (!ssm_wg) for (int r = gwx; r < NE * (I_GU + I_D); r += NGWX) {
        if (r < NE * I_GU) { const int e = r / I_GU, q = r % I_GU;
            transpose_item_q(a.in[27] + (size_t)e * D * 2 * DE, D, 2 * DE, (unsigned char*)(ws + WS_WGU) + (size_t)e * 2 * DE * D, scr, q, lane, PermGU{}, 16.0f); }
        else { const int r2 = r - NE * I_GU, e = r2 / I_D, q = r2 % I_D;
            transpose_item_q(a.in[29] + (size_t)e * DE * D, DE, D, (unsigned char*)(ws + WS_WD) + (size_t)e * D * DE, scr, q, lane, PermId{}, 32.0f); }
    }
    cvt_rows(a.in[1], (bf16*)(ws + WS_MEMB), (size_t)BATCH * NMEM * D, lane, wave);
    cvt_rows(a.in[0], (bf16*)(ws + WS_XB), (size_t)T * D, lane, wave, (unsigned char*)(ws + WS_XQ));
    { const int* pos = (const int*)a.in[2]; float* cs = (float*)(ws + WS_CS);
      for (int i = gw * 64 + lane; i < T * 32; i += NGW * 64) { const float inv = powf(10000.0f, -(float)(i & 31) / 32.0f); const float ang = (float)pos[i >> 5] * inv;
          *(f32x2*)(cs + 2 * (size_t)i) = (f32x2){cosf(ang), sinf(ang)}; } }
    for (int i = gw * 64 + lane; i < D * NE; i += NGW * 64) {
        const int j = i & 7, col = (i >> 3) & 31, h = (i >> 8) & 1, s = i >> 9;
        const float w = a.in[25][(size_t)(16 * s + 8 * h + j) * NE + col];
        const unsigned hb = cvt_pk_bf16(w, 0.f) & 0xffffu; const unsigned lb = cvt_pk_bf16(w - __uint_as_float(hb << 16), 0.f) & 0xffffu;
        ((bf16*)(ws + WS_WRF))[i] = (bf16)hb; ((bf16*)(ws + WS_WRF + 65536))[i] = (bf16)lb;
    }
}

enum { PH_PRO = 0, PH_INPROJ = 1, PH_KV = 2, PH_ATTN = 3, PH_SSMA = 4, PH_SSMB = 5, PH_SSMC = 6, PH_GLU = 7, PH_AOUT = 8, PH_WOUT = 9, PH_LN1 = 10,
       PH_QC = 11, PH_S = 12, PH_PV = 13, PH_WOC = 14, PH_LN2 = 15, PH_ROUTER = 16, PH_SLOTS = 17, PH_MOE1 = 18, PH_MOE2 = 19, PH_COMBINE = 20, PH_N = 21 };
__global__ void __launch_bounds__(NWAVES * 64, 2) mk_fwd(Args a) {
    extern __shared__ __attribute__((aligned(16))) unsigned char lds_raw[];
    LAS unsigned char* lds = (LAS unsigned char*)lds_raw;
    volatile LAS unsigned* MISC = (volatile LAS unsigned*)(lds + MISC_OFF);
    const int wave = __builtin_amdgcn_readfirstlane(threadIdx.x >> 6);
    for (int u = threadIdx.x; u < (LDS_BYTES - MISC_OFF) / 4; u += NWAVES * 64) ((LAS unsigned*)(lds + MISC_OFF))[u] = 0u;
    __syncthreads();
    unsigned char* ws = a.ws;
    XcdBarrier bar = xcd_barrier_post((unsigned*)(ws + WS_CTL) + CW_BAR, MISC + 8);
    const unsigned long long mask = a.mask;
#define RUN(k) ((mask >> (k)) & 1ull)
#define SEAM(k) do { if (mask >> ((k) + 1)) xcd_barrier(bar, wave); } while (0)

    if (RUN(PH_PRO)) { phase_prologue(a, lds, wave); SEAM(PH_PRO); }

    if (RUN(PH_INPROJ)) {
        { GridOrder S = grid_order(T, O_GA, 0, ws + WS_XB, D * 2, ws + WS_WIN, D * 2);
          EpiInproj E{(bf16*)(ws + WS_QR), (bf16*)(ws + WS_KR), (bf16*)(ws + WS_VR), (bf16*)(ws + WS_AS), (bf16*)(ws + WS_GA), (bf16*)(ws + WS_GS), (const float*)(ws + WS_CS), 0};
          pg8::gemm_phase<EpiInproj, GridOrder>(lds, pg8::Gemm{D * 2, D * 2, D}, S, E, wave); }
        { GridOrder S = grid_order(T, 2 * D, 0, ws + WS_XQ, D, ws + WS_WINQ, D);
          EpiInproj E{(bf16*)(ws + WS_QR), (bf16*)(ws + WS_KR), (bf16*)(ws + WS_VR), (bf16*)(ws + WS_AS), (bf16*)(ws + WS_GA), (bf16*)(ws + WS_GS), (const float*)(ws + WS_CS), 7};
          pg8::gemm_phase<EpiInproj, GridOrder, false, true>(lds, pg8::Gemm{D, D, D / 2, 0x7b7b7b7b, 0x7f7f7f7f}, S, E, wave); }
    }
    if (RUN(PH_KV)) {
        { GridOrder S = grid_order(BATCH * NMEM, D, 128, ws + WS_MEMB, D * 2, ws + WS_WK, D * 2);
          EpiBf16N8 E{(bf16*)(ws + WS_KC), D, 1.0f}; pg8::gemm_phase<EpiBf16N8, GridOrder>(lds, pg8::Gemm{D * 2, D * 2, D}, S, E, wave); }
        { GridOrder S = grid_order(D, BATCH * NMEM, 64, ws + WS_WV, D * 2, ws + WS_MEMB, D * 2);
          EpiBf16N8 E{(bf16*)(ws + WS_VCT), BATCH * NMEM, 1.0f}; pg8::gemm_phase<EpiBf16N8, GridOrder>(lds, pg8::Gemm{D * 2, D * 2, D}, S, E, wave); }
    }
    if (RUN(PH_INPROJ) || RUN(PH_KV)) SEAM(PH_KV);
    if (RUN(PH_ATTN)) phase_attn(a, lds, wave, (const bf16*)(ws + WS_QR), (const bf16*)(ws + WS_KR), (const bf16*)(ws + WS_VR), (bf16*)(ws + WS_AO));
    if (RUN(PH_SSMA)) {
        SsmOrder S{(int)gridDim.x, (int)((blockIdx.x + 128u) % gridDim.x), 1, (const char*)(ws + WS_AS), (const char*)(ws + WS_BTST), (size_t)256 * 512 * 2, 0};
        EpiState E{(float*)(ws + WS_SST)};
        pg8::gemm_phase<EpiState, SsmOrder>(lds, pg8::Gemm{SSM_K * 2, 512 * 2, 512}, S, E, wave);
    }
    if (RUN(PH_ATTN) || RUN(PH_SSMA)) SEAM(PH_SSMA);
    if (RUN(PH_SSMB)) { phase_ssmb(wave, (const float*)(ws + WS_SST), (const float*)(ws + WS_ABARL), (bf16*)(ws + WS_AS)); SEAM(PH_SSMB); }
    if (RUN(PH_SSMC)) {
        SsmOrder S{(int)gridDim.x, (int)blockIdx.x, 2, (const char*)(ws + WS_AS), (const char*)(ws + WS_BTS), (size_t)512 * SSM_K * 2, (size_t)256 * SSM_K * 2};
        EpiSsmOut E{(const bf16*)(ws + WS_AS), a.in[13], (unsigned char*)(ws + WS_Z)};
        pg8::gemm_phase<EpiSsmOut, SsmOrder>(lds, pg8::Gemm{SSM_K * 2, SSM_K * 2, SSM_K}, S, E, wave);
        SEAM(PH_SSMC);
    }
    if (RUN(PH_GLU)) {
        GridOrder S = grid_order(T, 2 * D, 0, ws + WS_Z, SSMW, ws + WS_WGLU, SSMW);
        EpiGlu E{(const bf16*)(ws + WS_GS), (bf16*)(ws + WS_SG)};
        pg8::gemm_phase<EpiGlu, GridOrder, false, true>(lds, pg8::Gemm{SSMW, SSMW, SSMW / 2, 0x7b7b7b7b, 0x7f7f7f7f}, S, E, wave);
        SEAM(PH_GLU);
    }
    if (RUN(PH_AOUT)) {
        GridOrder S = grid_order(T, D, 0, ws + WS_AO, D * 2, ws + WS_WAO, D * 2);
        EpiMixB E{(const bf16*)(ws + WS_GA), (const bf16*)(ws + WS_SG), (bf16*)(ws + WS_MIX)};
        pg8::gemm_phase<EpiMixB, GridOrder>(lds, pg8::Gemm{D * 2, D * 2, D}, S, E, wave);
        SEAM(PH_AOUT);
    }
    if (RUN(PH_WOUT)) {
        GridOrder S = grid_order(T, D, 0, ws + WS_MIX, D * 2, ws + WS_WOUT, D * 2);
        EpiResF32 E{(bf16*)(ws + WS_PRE1), a.in[0]}; pg8::gemm_phase<EpiResF32, GridOrder>(lds, pg8::Gemm{D * 2, D * 2, D}, S, E, wave);
        SEAM(PH_WOUT);
    }
    if (RUN(PH_LN1)) { phase_ln((const bf16*)(ws + WS_PRE1), a.in[17], a.in[18], nullptr, (bf16*)(ws + WS_X1B), nullptr, wave); SEAM(PH_LN1); }
    if (RUN(PH_QC)) {
        GridOrder S = grid_order(T, D, 0, ws + WS_X1B, D * 2, ws + WS_WQ, D * 2);
        EpiBf16N8 E{(bf16*)(ws + WS_QC), D, 0.0625f}; pg8::gemm_phase<EpiBf16N8, GridOrder>(lds, pg8::Gemm{D * 2, D * 2, D}, S, E, wave);
        SEAM(PH_QC);
    }
    if (RUN(PH_S)) {
        BhOrder S{(int)gridDim.x, (int)blockIdx.x, (const char*)(ws + WS_QC), (const char*)(ws + WS_KC), (size_t)SEQ * D * 2, (size_t)256 * D * 2, (size_t)CHD * 2, (size_t)NMEM * D * 2, (size_t)CHD * 2};
        EpiSoftmax E{(bf16*)(ws + WS_PM), D, (LAS f32x2*)(lds + MISC_OFF + 4096)};
        pg8::gemm_phase<EpiSoftmax, BhOrder>(lds, pg8::Gemm{D * 2, D * 2, CHD}, S, E, wave);
        SEAM(PH_S);
    }
    if (RUN(PH_PV)) {
        BhOrder S{(int)gridDim.x, (int)blockIdx.x, (const char*)(ws + WS_PM), (const char*)(ws + WS_VCT), (size_t)SEQ * D * 2, (size_t)256 * D * 2, (size_t)NMEM * 2, (size_t)NMEM * 2, (size_t)CHD * BATCH * NMEM * 2};
        EpiBf16N8 E{(bf16*)(ws + WS_OC), D, 1.0f};
        pg8::gemm_phase<EpiBf16N8, BhOrder>(lds, pg8::Gemm{D * 2, BATCH * NMEM * 2, NMEM}, S, E, wave);
        SEAM(PH_PV);
    }
    if (RUN(PH_WOC)) {
        GridOrder S = grid_order(T, D, 0, ws + WS_OC, D * 2, ws + WS_WOC, D * 2);
        EpiResB16 E{(bf16*)(ws + WS_PRE2), (const bf16*)(ws + WS_X1B)}; pg8::gemm_phase<EpiResB16, GridOrder>(lds, pg8::Gemm{D * 2, D * 2, D}, S, E, wave);
        SEAM(PH_WOC);
    }
    if (RUN(PH_LN2)) { phase_ln<true>((const bf16*)(ws + WS_PRE2), a.in[23], a.in[24], (float*)(ws + WS_X2), nullptr, (unsigned char*)(ws + WS_X2B), wave);
        asm volatile("s_waitcnt vmcnt(0)" ::: "memory"); __syncthreads(); }
    if (RUN(PH_ROUTER)) { phase_router(a, lds, wave); SEAM(PH_ROUTER); }
    if (RUN(PH_SLOTS)) { phase_slots(a, wave); SEAM(PH_SLOTS); }
    if (RUN(PH_MOE1)) {
        int stl; const int ntot = expert_tiles(a, lane_id_v(), stl);
        MoeOrder S{stl, ntot, 3, (int)gridDim.x, (int)blockIdx.x, (const char*)(ws + WS_X2B), (const char*)(ws + WS_WGU), (size_t)0, (size_t)256 * D, (size_t)2 * DE * D, (const int*)(ws + WS_SLOTTOK)};
        EpiSwigluB E{(unsigned char*)(ws + WS_RB), a.in[28]};
        pg8::gemm_phase<EpiSwigluB, MoeOrder, true, true>(lds, pg8::Gemm{D, D, D / 2, 0x7b7b7b7b, 0x7f7f7f7f}, S, E, wave);
        SEAM(PH_MOE1);
    }
    if (RUN(PH_MOE2)) {
        int stl; const int ntot = expert_tiles(a, lane_id_v(), stl);
        MoeOrder S{stl, ntot, 2, (int)gridDim.x, (int)blockIdx.x, (const char*)(ws + WS_RB), (const char*)(ws + WS_WD), (size_t)256 * DE, (size_t)256 * DE, (size_t)D * DE, nullptr};
        EpiDownB E{(bf16*)(ws + WS_RA), a.in[30], (const float*)(ws + WS_SLOTGATE)};
        pg8::gemm_phase<EpiDownB, MoeOrder, false, true>(lds, pg8::Gemm{DE, DE, DE / 2, 0x7a7a7a7a, 0x7f7f7f7f}, S, E, wave);
        SEAM(PH_MOE2);
    }
    if (RUN(PH_COMBINE)) { phase_combine(a, wave); }
#undef RUN
#undef SEAM
}

extern "C" void kernel_launch(void* const* d_in, const int* in_sizes, int n_in, void* d_out, int out_size, void* d_ws, size_t ws_size, hipStream_t stream) {
    static int ready = 0;
    if (!ready) {
        if (n_in != 33 || ws_size < WS_END) { fprintf(stderr, "kernel_launch: unexpected n_in %d / ws_size %zu\n", n_in, ws_size); ready = -1; return; }
        if (hipFuncSetAttribute((const void*)mk_fwd, hipFuncAttributeMaxDynamicSharedMemorySize, LDS_BYTES) != hipSuccess) { fprintf(stderr, "hipFuncSetAttribute failed\n"); ready = -1; return; }
        ready = 1;
    }
    if (ready < 0) return;
    char* ws = (char*)d_ws;
    (void)hipMemsetAsync(ws + WS_CTL, 0, CTL_ZERO_BYTES, stream);
    Args a{};
    for (int i = 0; i < 33; ++i) a.in[i] = (const float*)d_in[i];
    a.out = (float*)d_out; a.ws = (unsigned char*)d_ws;
    a.mask = (1ull << PH_N) - 1ull;
    hipLaunchKernelGGL(mk_fwd, dim3(256), dim3(NWAVES * 64), LDS_BYTES, stream, a);
}
```
